# Optimizing an MI355X kernel written in HIP

```python
import math
import jax, jax.numpy as jnp
from jax import lax
import numpy as np


D_MODEL = 1024
BATCH = 2
SEQ = 16384
DEPTH = 2

GRID_W = 64
CTX_LEN = 256
D_MIX = D_MODEL
D_POOL = D_MIX // 2
POOL_WINDOWS = (2, 4, 8, 16)
N_POOL_GROUPS = len(POOL_WINDOWS)
POOL_GC = D_POOL // N_POOL_GROUPS
D_ATTN = D_MIX - D_POOL
ATTN_HEAD_DIM = 64
N_ATTN_HEADS = D_ATTN // (2 * ATTN_HEAD_DIM)
ROPE_THETA = 10000.0
Q_BLOCK = 128
Q_OFF = D_POOL
K_OFF = Q_OFF + D_ATTN
V_OFF = K_OFF + D_ATTN
D_IN = V_OFF + D_ATTN
N_GROUPS = 4
EXPERTS_PER_GROUP = 8
N_EXPERTS = N_GROUPS * EXPERTS_PER_GROUP
TOP_K_FINE = 2
D_EXPERT = 256
EPS = 1e-6

kernel_name = 'hybrid_pool_diffattn_hmoe_dit'


def rmsnorm(x, g):
    xf = x.astype(jnp.float32)
    y = xf * lax.rsqrt(jnp.mean(xf * xf, axis=-1, keepdims=True) + EPS)
    return (y * g.astype(jnp.float32)).astype(x.dtype)


def modulate(h, shift, scale):
    return h * (1 + scale) + shift


def axial_rope_tables(n_tokens, dtype):
    rows = n_tokens // GRID_W
    row = jnp.repeat(jnp.arange(rows, dtype=jnp.int32), GRID_W)
    col = jnp.tile(jnp.arange(GRID_W, dtype=jnp.int32), rows)
    n_freq = ATTN_HEAD_DIM // 4
    inv = ROPE_THETA ** (-jnp.arange(n_freq, dtype=jnp.float32) / n_freq)
    ang_r = (row[:, None].astype(jnp.float32) * inv)[:, None, None, :]
    ang_c = (col[:, None].astype(jnp.float32) * inv)[:, None, None, :]
    return (jnp.cos(ang_r).astype(dtype), jnp.sin(ang_r).astype(dtype),
            jnp.cos(ang_c).astype(dtype), jnp.sin(ang_c).astype(dtype))


def _rope_half(x, cos, sin):
    x1, x2 = jnp.split(x, 2, axis=-1)
    return jnp.concatenate([x1 * cos - x2 * sin, x2 * cos + x1 * sin], axis=-1)


def apply_axial_rope(x, tables):
    cos_r, sin_r, cos_c, sin_c = tables
    half = ATTN_HEAD_DIM // 2
    return jnp.concatenate([_rope_half(x[..., :half], cos_r, sin_r),
                            _rope_half(x[..., half:], cos_c, sin_c)], axis=-1)


def heads_qk(p):
    return p.reshape(*p.shape[:-1], N_ATTN_HEADS, 2, ATTN_HEAD_DIM)


def heads_v(p):
    return p.reshape(*p.shape[:-1], N_ATTN_HEADS, 2 * ATTN_HEAD_DIM)


def pool_mixer(u, pool_w, pool_scale):
    b, n, _ = u.shape
    uf = u.reshape(b, n, N_POOL_GROUPS, POOL_GC).astype(jnp.float32)
    csum = jnp.concatenate([jnp.zeros_like(uf[:, :1]), jnp.cumsum(uf, axis=1)], axis=1)
    t = jnp.arange(n)
    outs = []
    for g, w in enumerate(POOL_WINDOWS):
        left = w // 2
        right = w - 1 - left
        lo = jnp.clip(t - left, 0, n)
        hi = jnp.clip(t + right + 1, 0, n)
        cnt = (hi - lo).astype(jnp.float32)[None, :, None]
        outs.append((csum[:, hi, g] - csum[:, lo, g]) / cnt - uf[:, :, g])
    pooled = jnp.stack(outs, axis=2).astype(u.dtype)
    mixed = jnp.einsum('blgc,gce->blge', pooled, pool_w)
    return mixed.reshape(b, n, D_POOL) * pool_scale


def diff_attend(q, k, v, lam):
    s = jnp.einsum('bqhmd,bkhmd->bhmqk', q, k).astype(jnp.float32) * (ATTN_HEAD_DIM ** -0.5)
    p = jax.nn.softmax(s, axis=-1)
    a = p[:, :, 0] - lam * p[:, :, 1]
    return jnp.einsum('bhqk,bkhe->bqhe', a.astype(v.dtype), v)


def diff_attention_latent(q, k, v, k_ctx, v_ctx, lam):
    keys = jnp.concatenate([k, k_ctx], axis=1)
    vals = jnp.concatenate([v, v_ctx], axis=1)
    b, n = q.shape[:2]
    nb = n // Q_BLOCK
    qb = q.reshape(b, nb, Q_BLOCK, N_ATTN_HEADS, 2, ATTN_HEAD_DIM).transpose(1, 0, 2, 3, 4, 5)
    out = lax.map(lambda qblk: diff_attend(qblk, keys, vals, lam), qb)
    return out.transpose(1, 0, 2, 3, 4).reshape(b, n, N_ATTN_HEADS, 2 * ATTN_HEAD_DIM)


def merge_head_groups(u, attn, pool_w, pool_scale, subln_g, lam_init, w_out):
    pool = pool_mixer(u, pool_w, pool_scale)
    attn = rmsnorm(attn, subln_g) * (1 - lam_init)
    attn = attn.reshape(*attn.shape[:2], D_ATTN)
    return jnp.concatenate([pool, attn], axis=-1) @ w_out


def hier_moe(h, rc_w, rc_b, rf_w, rf_b, w_gate, w_up, w_down):
    shp = h.shape
    t = h.reshape(-1, D_MODEL)
    n = t.shape[0]
    logits_c = (t @ rc_w + rc_b).astype(jnp.float32)
    probs_c = jax.nn.softmax(logits_c, axis=-1)
    _, top_g = lax.top_k(logits_c, 1)
    g_idx = top_g[:, 0]
    p_group = jnp.take_along_axis(probs_c, top_g, axis=-1)
    logits_f = (t @ rf_w + rf_b).astype(jnp.float32).reshape(n, N_GROUPS, EXPERTS_PER_GROUP)
    lf = logits_f[jnp.arange(n), g_idx]
    top_v, top_i = lax.top_k(lf, TOP_K_FINE)
    w_top = jax.nn.softmax(top_v, axis=-1) * p_group
    expert_id = g_idx[:, None] * EXPERTS_PER_GROUP + top_i
    gates = jnp.einsum('nk,nke->ne', w_top, jax.nn.one_hot(expert_id, N_EXPERTS, dtype=jnp.float32))
    gates = gates.reshape(n, N_GROUPS, EXPERTS_PER_GROUP).astype(t.dtype)
    out = jnp.zeros_like(t)
    for g in range(N_GROUPS):
        a = jnp.einsum('nd,edf->nef', t, w_gate[g])
        bu = jnp.einsum('nd,edf->nef', t, w_up[g])
        hid = jax.nn.silu(a) * bu * gates[:, g, :, None]
        out = out + jnp.einsum('nef,efd->nd', hid, w_down[g])
    return out.reshape(shp)


def setup_inputs(seed: int = 0) -> dict:
    key = jax.random.key(seed)
    ks = jax.random.split(key, 26)
    f32 = jnp.float32
    nrm = lambda k, s: jax.random.normal(k, s, f32)
    D = D_MODEL
    return {
        'x': nrm(ks[0], (BATCH, SEQ, D)),
        'c': nrm(ks[1], (BATCH, D)),
        'ctx': nrm(ks[2], (BATCH, CTX_LEN, D)),
        'c_ctx': nrm(ks[3], (D,)),
        'ada_w': nrm(ks[4], (DEPTH, D, 6 * D)) * (0.5 * D ** -0.5),
        'ada_b': nrm(ks[5], (DEPTH, 6 * D)) * 0.01,
        'norm1_g': 1.0 + 0.05 * nrm(ks[6], (DEPTH, D)),
        'norm2_g': 1.0 + 0.05 * nrm(ks[7], (DEPTH, D)),
        'w_in': nrm(ks[8], (DEPTH, D, D_IN)) * D ** -0.5,
        'pool_w': nrm(ks[9], (DEPTH, N_POOL_GROUPS, POOL_GC, POOL_GC)) * POOL_GC ** -0.5,
        'pool_scale': 1.0 + 0.1 * nrm(ks[10], (DEPTH, D_POOL)),
        'lambda_q1': 0.1 * nrm(ks[11], (DEPTH, ATTN_HEAD_DIM)),
        'lambda_k1': 0.1 * nrm(ks[12], (DEPTH, ATTN_HEAD_DIM)),
        'lambda_q2': 0.1 * nrm(ks[13], (DEPTH, ATTN_HEAD_DIM)),
        'lambda_k2': 0.1 * nrm(ks[14], (DEPTH, ATTN_HEAD_DIM)),
        'subln_g': 1.0 + 0.05 * nrm(ks[15], (DEPTH, 2 * ATTN_HEAD_DIM)),
        'w_out': nrm(ks[16], (DEPTH, D_MIX, D)) * D_MIX ** -0.5,
        'router_coarse_w': nrm(ks[17], (DEPTH, D, N_GROUPS)) * D ** -0.5,
        'router_coarse_b': 0.01 * nrm(ks[18], (DEPTH, N_GROUPS)),
        'router_fine_w': nrm(ks[19], (DEPTH, D, N_EXPERTS)) * D ** -0.5,
        'router_fine_b': 0.01 * nrm(ks[20], (DEPTH, N_EXPERTS)),
        'w_gate': nrm(ks[21], (DEPTH, N_GROUPS, EXPERTS_PER_GROUP, D, D_EXPERT)) * D ** -0.5,
        'w_up': nrm(ks[22], (DEPTH, N_GROUPS, EXPERTS_PER_GROUP, D, D_EXPERT)) * D ** -0.5,
        'w_down': nrm(ks[23], (DEPTH, N_GROUPS, EXPERTS_PER_GROUP, D_EXPERT, D)) * D_EXPERT ** -0.5,
        'final_g': 1.0 + 0.05 * nrm(ks[24], (D,)),
    }


def reference(x, c, ctx, c_ctx, ada_w, ada_b, norm1_g, norm2_g, w_in, pool_w, pool_scale,
              lambda_q1, lambda_k1, lambda_q2, lambda_k2, subln_g, w_out,
              router_coarse_w, router_coarse_b, router_fine_w, router_fine_b,
              w_gate, w_up, w_down, final_g):
    n_lat = x.shape[1]
    tables = axial_rope_tables(n_lat, x.dtype)
    xc = ctx
    s_x = jax.nn.silu(c)
    s_c = jax.nn.silu(c_ctx)
    for layer in range(DEPTH):
        last = layer == DEPTH - 1
        lam_init = 0.8 - 0.6 * math.exp(-0.3 * layer)
        mod_x = (s_x @ ada_w[layer] + ada_b[layer])[:, None, :]
        mod_c = (s_c @ ada_w[layer] + ada_b[layer])[None, None, :]
        sh1, sc1, g1, sh2, sc2, g2 = jnp.split(mod_x, 6, axis=-1)
        csh1, csc1, cg1, csh2, csc2, cg2 = jnp.split(mod_c, 6, axis=-1)
        lam = (jnp.exp(jnp.sum(lambda_q1[layer] * lambda_k1[layer]).astype(jnp.float32))
               - jnp.exp(jnp.sum(lambda_q2[layer] * lambda_k2[layer]).astype(jnp.float32))
               + lam_init)

        hx = modulate(rmsnorm(x, norm1_g[layer]), sh1, sc1)
        hc = modulate(rmsnorm(xc, norm1_g[layer]), csh1, csc1)
        px = hx @ w_in[layer]
        u_x = px[..., :Q_OFF]
        q_x = apply_axial_rope(heads_qk(px[..., Q_OFF:K_OFF]), tables)
        k_x = apply_axial_rope(heads_qk(px[..., K_OFF:V_OFF]), tables)
        v_x = heads_v(px[..., V_OFF:])
        col0 = K_OFF if last else 0
        pc = hc @ w_in[layer][:, col0:]
        k_c = heads_qk(pc[..., K_OFF - col0:V_OFF - col0])
        v_c = heads_v(pc[..., V_OFF - col0:])
        attn_x = diff_attention_latent(q_x, k_x, v_x, k_c, v_c, lam)
        mix_x = merge_head_groups(u_x, attn_x, pool_w[layer], pool_scale[layer], subln_g[layer],
                                  lam_init, w_out[layer])
        if not last:
            q_c = heads_qk(pc[..., Q_OFF:K_OFF])
            attn_c = diff_attend(q_c, k_c, v_c, lam)
            mix_c = merge_head_groups(pc[..., :Q_OFF], attn_c, pool_w[layer], pool_scale[layer],
                                      subln_g[layer], lam_init, w_out[layer])
            xc = xc + cg1 * mix_c
        x = x + g1 * mix_x

        hx2 = modulate(rmsnorm(x, norm2_g[layer]), sh2, sc2)
        moe_args = (router_coarse_w[layer], router_coarse_b[layer], router_fine_w[layer],
                    router_fine_b[layer], w_gate[layer], w_up[layer], w_down[layer])
        if last:
            x = x + g2 * hier_moe(hx2, *moe_args)
        else:
            hc2 = modulate(rmsnorm(xc, norm2_g[layer]), csh2, csc2)
            n_ctx = xc.shape[1]
            f = hier_moe(jnp.concatenate([hc2, hx2], axis=1), *moe_args)
            xc = xc + cg2 * f[:, :n_ctx]
            x = x + g2 * f[:, n_ctx:]
    return rmsnorm(x, final_g)
```

```cpp
#include <hip/hip_runtime.h>
#include <cstdio>
#include <cstdint>

#ifndef MK_PER_PHASE
#define MK_PER_PHASE 0
#endif
#ifndef DBG_CHECK
#define DBG_CHECK 0
#endif

#define GAS __attribute__((address_space(1)))
#define LAS __attribute__((address_space(3)))
typedef unsigned short bf16;
typedef unsigned u32x4 __attribute__((ext_vector_type(4)));
typedef unsigned u32x2 __attribute__((ext_vector_type(2)));
typedef float f32x4 __attribute__((ext_vector_type(4)));
typedef float f32x2 __attribute__((ext_vector_type(2)));
typedef float f32x16 __attribute__((ext_vector_type(16)));
typedef short bf16x8 __attribute__((ext_vector_type(8)));
typedef short s16x4 __attribute__((ext_vector_type(4)));
typedef GAS unsigned gu32;

constexpr int DM = 1024, NB = 2, SEQ = 16384, NCTX = 256, MC = NB * NCTX, ML = NB * SEQ, MT = MC + ML;
constexpr int DIN = 2048, DPOOL = 512, NH = 4, HD = 64, HV = 128, NEXP = 32, DEXP = 256, NLAYER = 2, GRIDW = 64;
constexpr float EPS = 1e-6f;
constexpr float QSCALE = 0.125f * 1.4426950408889634f;
constexpr int CAP = MT;
constexpr int NPH = 2 + 7 * NLAYER;

constexpr size_t MiB = 1u << 20;
constexpr size_t WS_CTL = 0, CTL_ZERO_BYTES = 1 * MiB;
constexpr size_t WS_SMALL = 1 * MiB;
constexpr size_t SM_MOD = 0, SM_ROPE = 163840, SM_LAM = 200704, SM_DUMMY = 262144;
constexpr size_t WS_WIN = 2 * MiB, WS_W2 = 10 * MiB, WS_WGU = 14 * MiB, WS_WD = 78 * MiB;
constexpr size_t WS_X = 110 * MiB;
constexpr size_t WS_HX = 240 * MiB;
constexpr size_t WS_U = 305 * MiB;
constexpr size_t SZ_QKV = (size_t)MT * 512 * 2;
constexpr size_t WS_HID = 435 * MiB;
constexpr size_t WS_LIST = 472 * MiB, WS_GW = 477 * MiB, WS_END = 482 * MiB;
constexpr int CW_TMO = 0, CW_CODE = 1, CW_BAR = 4096, CW_CNT = 16384  , CW_DBG = 32768;
constexpr int CW_TICK = 30720;
constexpr int CW_KMAX = 24576;

constexpr int RING_BYTES = 131072;
constexpr int UL_OFF = 131072;
constexpr int MISC_OFF = 147456;
constexpr int RT_OFF = MISC_OFF + 1024;
constexpr int LDS_BYTES = 155648;

__device__ __forceinline__ float bf2f(unsigned b) { return __builtin_bit_cast(float, b << 16); }
__device__ __forceinline__ unsigned cvt_pk_bf16(float lo, float hi) { unsigned r; asm volatile("v_cvt_pk_bf16_f32 %0, %1, %2" : "=v"(r) : "v"(lo), "v"(hi)); return r; }
#define LDS_WAIT() asm volatile("s_waitcnt lgkmcnt(0)" ::: "memory")
#define VM_WAIT() asm volatile("s_waitcnt vmcnt(0)" ::: "memory")
#define RLX_AGENT __ATOMIC_RELAXED, __HIP_MEMORY_SCOPE_AGENT

namespace pg8 {
constexpr int BM = 256, BK = 64, HALF = 128, HTB = HALF * BK * 2, STAGE_BYTES = 8 * HTB, NXCD = 8, WGM = 8;
__host__ __device__ __forceinline__ int lds_byte(int r, int c) { const int st = (r >> 4) * 2 + (c >> 5), rr = r & 15, cc = c & 31, ob = rr * 64 + cc * 2; return st * 1024 + (ob ^ (((ob >> 9) & 1) << 5)); }
__host__ __device__ __forceinline__ void stage_rc(int b, int& R, int& C) { const int st = b / 1024, sb = b % 1024, swz = sb ^ (((sb >> 9) & 1) << 5); R = (st >> 1) * 16 + swz / 64; C = (st & 1) * 32 + (swz % 64) / 2; }
__host__ __device__ __forceinline__ int perm32(int rho) { const int n = rho >> 4, i = rho & 15; return 8 * (i >> 2) + 4 * n + (i & 3); }

struct Unit { int pm, pn, ui; };
struct Gemm { const bf16* A; const bf16* Bt; int M, N, K; };

struct StaticOrder {
    int nM, nN, nwg, G, c;
    __device__ void init(int M, int N, int G_, int c_) { nM = M / BM; nN = N / BM; nwg = nM * nN; G = G_; c = c_; }
    __device__ bool next(int i, Unit& u) const {
        const long L = (long)i * G + c; if (L >= nwg) return false;
        int wgid = (int)L; { const int q = nwg / NXCD, r = nwg % NXCD, xcd = wgid % NXCD, off = wgid / NXCD; wgid = (xcd < r ? xcd * (q + 1) : r * (q + 1) + (xcd - r) * q) + off; }
        const int nig = WGM * nN, gid = wgid / nig, fm = gid * WGM, gsz = (nM - fm) < WGM ? (nM - fm) : WGM;
        u.pm = fm + ((wgid % nig) % gsz); u.pn = (wgid % nig) / gsz; u.ui = i; return true;
    }
};
struct MoeOrder {
    const volatile LAS int* T;
    __device__ bool next(int i, Unit& u) const {
        if (i >= __builtin_amdgcn_readfirstlane(T[0])) return false;
        u.pm = __builtin_amdgcn_readfirstlane(T[2 + 2 * i]); u.pn = __builtin_amdgcn_readfirstlane(T[3 + 2 * i]); u.ui = i; return true;
    }
};

template <class Epi, class Sched, bool ALIGN_EPI, bool GATHER>
__device__ __forceinline__ void gemm_phase(LAS unsigned char* lds, const Gemm g, const Sched& S, const Epi& E) {
    const int tid = threadIdx.x, wid = __builtin_amdgcn_readfirstlane(tid >> 6), lane = tid & 63, wr = wid >> 2, wc = wid & 3, fr = lane & 15, fq = lane >> 4;
    const int K = g.K, nt = K / BK;
    unsigned voffA[2], voffB[2];
#pragma unroll
    for (int i = 0; i < 2; ++i) { int R, C; stage_rc(tid * 16 + i * 8192, R, C); const int Rb = (R & ~31) + perm32(R & 31);
        voffA[i] = (unsigned)(R * K + C) * 2u; voffB[i] = (unsigned)(Rb * K + C) * 2u; }
    const size_t kstep = (size_t)(BK * 2);
    const size_t hstep = (size_t)HALF * K * 2;
    const size_t tstep = 2 * hstep;
    const unsigned ldsw = (unsigned)wid * 1024u;
    const int aoff = lds_byte(wr * 64 + fr, fq * 8), boff = lds_byte(wc * 32 + fr, fq * 8);
    const volatile LAS unsigned* ultok = (const volatile LAS unsigned*)(lds + UL_OFF);
#define PG8_SA(b, h) (((b) * 2 + (h)) * HTB)
#define PG8_SB(b, h) ((4 + (b) * 2 + (h)) * HTB)
#define PG8_STAGE(bufoff, gbase, voff) do { _Pragma("unroll") for (int _i = 0; _i < 2; ++_i) \
        __builtin_amdgcn_global_load_lds((const unsigned*)((const char*)(gbase) + (voff)[_i]), (LAS unsigned*)(lds + (bufoff) + ldsw + _i * 8192), 16, 0, 0); } while (0)
#define PG8_STA(bufoff, ptr, h, OFFS) do { if constexpr (GATHER) { PG8_STAGE(bufoff, ptr, OFFS[h]); } else { PG8_STAGE(bufoff, (ptr) + (h) * hstep, voffA); } } while (0)
#define PG8_GOFF(dst, U) do { _Pragma("unroll") for (int _h = 0; _h < 2; ++_h) _Pragma("unroll") for (int _i = 0; _i < 2; ++_i) { int _R, _C; stage_rc(tid * 16 + _i * 8192, _R, _C); \
        const unsigned _t = ultok[(U).ui * 256 + _h * 128 + _R]; const unsigned _row = (_t == 0xFFFFFFFFu) ? 0u : (_t >> 1); dst[_h][_i] = _row * (unsigned)(K * 2) + (unsigned)_C * 2u; } } while (0)
#define PG8_LDA(dst, b, h) do { _Pragma("unroll") for (int m = 0; m < 4; ++m) _Pragma("unroll") for (int k = 0; k < 2; ++k) dst[m][k] = *(const LAS bf16x8*)(lds + PG8_SA(b, h) + aoff + m * 2048 + k * 1024); } while (0)
#define PG8_LDB(dst, b, h) do { _Pragma("unroll") for (int n = 0; n < 2; ++n) _Pragma("unroll") for (int k = 0; k < 2; ++k) dst[n][k] = *(const LAS bf16x8*)(lds + PG8_SB(b, h) + boff + n * 2048 + k * 1024); } while (0)
#define PG8_MMA(ai, bj, At, Bt) do { __builtin_amdgcn_s_setprio(1); _Pragma("unroll") for (int m = 0; m < 4; ++m) _Pragma("unroll") for (int n = 0; n < 2; ++n) _Pragma("unroll") for (int k = 0; k < 2; ++k) \
        acc[ai][bj][m][n] = __builtin_amdgcn_mfma_f32_16x16x32_bf16(Bt[n][k], At[m][k], acc[ai][bj][m][n], 0, 0, 0); __builtin_amdgcn_s_setprio(0); } while (0)
#define PG8_WAIT_V(n) asm volatile("s_waitcnt vmcnt(" #n ")" ::: "memory")
#define PG8_WAIT_L(n) asm volatile("s_waitcnt lgkmcnt(" #n ")" ::: "memory")
#define PG8_BAR __builtin_amdgcn_s_barrier()
#define PG8_SCHED __builtin_amdgcn_sched_barrier(0)
    Unit cur, nxt; int ui = 0;
    if (!S.next(0, cur)) return;
    f32x4 acc[2][2][4][2];
#pragma unroll
    for (int a = 0; a < 2; ++a)
#pragma unroll
        for (int b = 0; b < 2; ++b)
#pragma unroll
            for (int m = 0; m < 4; ++m)
#pragma unroll
                for (int n = 0; n < 2; ++n) acc[a][b][m][n] = (f32x4){0.f, 0.f, 0.f, 0.f};
    bf16x8 At[4][2], B0[2][2], B1[2][2];
    unsigned goff[2][2] = {{0u, 0u}, {0u, 0u}};
    const char* cA = GATHER ? (const char*)g.A : (const char*)g.A + (size_t)cur.pm * tstep; const char* cB = (const char*)g.Bt + (size_t)cur.pn * tstep;
    if constexpr (GATHER) { PG8_GOFF(goff, cur); }
    PG8_STAGE(PG8_SB(0, 0), cB, voffB); PG8_STAGE(PG8_SB(0, 1), cB + hstep, voffB); PG8_STA(PG8_SA(0, 0), cA, 0, goff); PG8_STA(PG8_SA(0, 1), cA, 1, goff);
    if (wr == 1) PG8_BAR;
    PG8_WAIT_V(2); PG8_BAR;
    PG8_STAGE(PG8_SB(1, 0), cB + kstep, voffB); PG8_STA(PG8_SA(1, 0), cA + kstep, 0, goff); PG8_STAGE(PG8_SB(1, 1), cB + hstep + kstep, voffB);
    PG8_WAIT_V(6); PG8_BAR;
    for (;;) {
        const bool has_next = S.next(ui + 1, nxt);
        const char* nA = GATHER ? (const char*)g.A : (has_next ? (const char*)g.A + (size_t)nxt.pm * tstep : cA); const char* nB = has_next ? (const char*)g.Bt + (size_t)nxt.pn * tstep : cB;
#pragma unroll 1
        for (int t = 0; t < nt; t += 2) {
            const bool last = (t == nt - 2);
            const char* a1 = cA + (size_t)(t + 1) * kstep;
            const char* a2 = last ? nA : cA + (size_t)(t + 2) * kstep; const char* b2 = last ? nB : cB + (size_t)(t + 2) * kstep;
            const char* a3 = a2 + kstep; const char* b3 = b2 + kstep;
            PG8_LDB(B0, 0, 0); PG8_LDB(B1, 0, 1); PG8_SCHED; PG8_LDA(At, 0, 0); PG8_STA(PG8_SA(1, 1), a1, 1, goff);
            if constexpr (GATHER) { if (last && has_next) { PG8_GOFF(goff, nxt); } }
            PG8_WAIT_V(8); PG8_WAIT_L(0); PG8_BAR; PG8_MMA(0, 0, At, B0); PG8_MMA(0, 1, At, B1); PG8_BAR; PG8_SCHED;
            PG8_LDA(At, 0, 1); PG8_STAGE(PG8_SB(0, 0), b2, voffB); PG8_STAGE(PG8_SB(0, 1), b2 + hstep, voffB); PG8_STA(PG8_SA(0, 0), a2, 0, goff);
            PG8_WAIT_V(8); PG8_WAIT_L(0); PG8_BAR; PG8_MMA(1, 0, At, B0); PG8_MMA(1, 1, At, B1); PG8_BAR; PG8_SCHED;
            PG8_LDB(B0, 1, 0); PG8_LDB(B1, 1, 1); PG8_SCHED; PG8_LDA(At, 1, 0); PG8_STA(PG8_SA(0, 1), a2, 1, goff);
            PG8_WAIT_V(8); PG8_WAIT_L(0); PG8_BAR; PG8_MMA(0, 0, At, B0); PG8_MMA(0, 1, At, B1); PG8_BAR; PG8_SCHED;
            PG8_LDA(At, 1, 1); PG8_STAGE(PG8_SB(1, 0), b3, voffB); PG8_STAGE(PG8_SB(1, 1), b3 + hstep, voffB); PG8_STA(PG8_SA(1, 0), a3, 0, goff);
            PG8_WAIT_V(8); PG8_WAIT_L(0); PG8_BAR; PG8_MMA(1, 0, At, B0); PG8_MMA(1, 1, At, B1); PG8_BAR; PG8_SCHED;
        }
        if constexpr (ALIGN_EPI) { if (wr == 0) PG8_BAR; }
        E(acc, cur, wr, wc, fr, fq);
        if (!has_next) break;
#pragma unroll
        for (int a = 0; a < 2; ++a)
#pragma unroll
            for (int b = 0; b < 2; ++b)
#pragma unroll
                for (int m = 0; m < 4; ++m)
#pragma unroll
                    for (int n = 0; n < 2; ++n) acc[a][b][m][n] = (f32x4){0.f, 0.f, 0.f, 0.f};
        cur = nxt; cA = nA; cB = nB; ++ui;
        if constexpr (ALIGN_EPI) { if (wr == 1) PG8_BAR; }
    }
    PG8_WAIT_V(0);
    if constexpr (!ALIGN_EPI) { if (wr == 0) PG8_BAR; }
    PG8_BAR;
#undef PG8_SA
#undef PG8_SB
#undef PG8_STAGE
#undef PG8_STA
#undef PG8_GOFF
#undef PG8_LDA
#undef PG8_LDB
#undef PG8_MMA
#undef PG8_WAIT_V
#undef PG8_WAIT_L
#undef PG8_BAR
#undef PG8_SCHED
}
}

#define XB_TMO      128
#define XB_XCNT(j)  (256  + 64 * (j))
#define XB_XSUB(j)  (1280 + 64 * (j))
#define XB_XGEN(j)  (2304 + 64 * (j))
#define XB_TOP      3328
#define XB_TOPGEN   3392
#define XCD_BAR_WORDS 3456
#define XB_SPIN_CAP (1u << 18)
__device__ __forceinline__ unsigned xb_ld(unsigned* p)              { return __hip_atomic_load(p, __ATOMIC_RELAXED, __HIP_MEMORY_SCOPE_AGENT); }
__device__ __forceinline__ unsigned xb_add(unsigned* p, unsigned v) { return __hip_atomic_fetch_add(p, v, __ATOMIC_RELAXED, __HIP_MEMORY_SCOPE_AGENT); }
__device__ __forceinline__ unsigned xb_xcc_id() { return (unsigned)__builtin_amdgcn_s_getreg((3 << 11) | 20) & 0xFu; }
#define XB_SPIN(cond, bar) do { unsigned _sp = 0; while (cond) { __builtin_amdgcn_s_sleep(1); \
    if ((++_sp & 255u) == 0u) { if (xb_ld(&(bar)[XB_TMO])) break; if (_sp > XB_SPIN_CAP) { atomicAdd(&(bar)[XB_TMO], 1u); break; } } } } while (0)
struct XcdBarrier { unsigned* bar; unsigned x; volatile LAS unsigned* st; };
__device__ __forceinline__ XcdBarrier xcd_barrier_post(unsigned* bar, volatile LAS unsigned* st) {
    XcdBarrier b; b.bar = bar; b.x = xb_xcc_id(); b.st = st;
    if (threadIdx.x == 0) (void)xb_add(&bar[XB_XCNT(b.x)], 1u);
    return b;
}
__device__ __forceinline__ void xcd_barrier_complete(unsigned* bar, unsigned x, unsigned& nloc, unsigned& nx) {
    const unsigned G = gridDim.x * gridDim.y * gridDim.z;
    unsigned sum, cnt, mine, sp = 0u;
    for (;;) {
        sum = 0u; cnt = 0u; mine = 0u;
#pragma unroll
        for (unsigned j = 0; j < 16; ++j) { const unsigned c = xb_ld(&bar[XB_XCNT(j)]); sum += c; cnt += (c > 0u) ? 1u : 0u; mine = (j == x) ? c : mine; }
        if (sum == G) break;
        __builtin_amdgcn_s_sleep(1);
        if ((++sp & 255u) == 0u) { if (xb_ld(&bar[XB_TMO])) break; if (sp > XB_SPIN_CAP) { atomicAdd(&bar[XB_TMO], 1u); break; } }
    }
    nloc = mine > 0u ? mine : 1u; nx = cnt > 0u ? cnt : 1u;
}
__device__ __forceinline__ void xcd_barrier(const XcdBarrier& b) {
    asm volatile("s_waitcnt vmcnt(0)" ::: "memory");
    __syncthreads();
    if (threadIdx.x == 0) {
        unsigned* bar = b.bar;
        __builtin_amdgcn_s_waitcnt(0);
        unsigned nloc = b.st[0], nx = b.st[1];
        if (nloc == 0u) { xcd_barrier_complete(bar, b.x, nloc, nx); b.st[0] = nloc; b.st[1] = nx; }
        const unsigned old = xb_add(&bar[XB_XSUB(b.x)], 1u);
        const unsigned gen = old / nloc;
        if (old + 1u == (gen + 1u) * nloc) {
            __builtin_amdgcn_fence(__ATOMIC_RELEASE, "agent");
            asm volatile("s_waitcnt vmcnt(0)" ::: "memory");
            const unsigned og = xb_add(&bar[XB_TOP], 1u);
            const unsigned tg = og / nx;
            if (og + 1u == (tg + 1u) * nx) xb_add(&bar[XB_TOPGEN], 1u);
            else XB_SPIN(xb_ld(&bar[XB_TOPGEN]) == tg, bar);
            __builtin_amdgcn_fence(__ATOMIC_ACQUIRE, "agent");
            xb_add(&bar[XB_XGEN(b.x)], 1u);
            asm volatile("s_waitcnt vmcnt(0)" ::: "memory");
        } else {
            XB_SPIN(xb_ld(&bar[XB_XGEN(b.x)]) == gen, bar);
            __builtin_amdgcn_fence(__ATOMIC_ACQUIRE, "agent");
            asm volatile("s_waitcnt vmcnt(0)" ::: "memory");
        }
    }
    __syncthreads();
}

struct Args { const float* in[25]; float* out; unsigned char* ws; int ph_lo, ph_hi; };
typedef const __attribute__((address_space(4))) Args* ArgsP;
struct Frame {
    LAS unsigned char* lds; volatile LAS unsigned* MISC; gu32* ctl; unsigned char* ws;
    int tid, lane, wave, G, c;
};
__device__ __forceinline__ float wave_sum(float v) {
    v += __builtin_bit_cast(float, __builtin_amdgcn_update_dpp(0, __builtin_bit_cast(int, v), 0xB1, 0xF, 0xF, true));
    v += __builtin_bit_cast(float, __builtin_amdgcn_update_dpp(0, __builtin_bit_cast(int, v), 0x4E, 0xF, 0xF, true));
    v += __builtin_bit_cast(float, __builtin_amdgcn_update_dpp(0, __builtin_bit_cast(int, v), 0x141, 0xF, 0xF, true));
    v += __builtin_bit_cast(float, __builtin_amdgcn_update_dpp(0, __builtin_bit_cast(int, v), 0x140, 0xF, 0xF, true));
    { auto rr = __builtin_amdgcn_permlane16_swap(__float_as_uint(v), __float_as_uint(v), false, false); v = __uint_as_float(rr[0]) + __uint_as_float(rr[1]); }
    { auto rr = __builtin_amdgcn_permlane32_swap(__float_as_uint(v), __float_as_uint(v), false, false); v = __uint_as_float(rr[0]) + __uint_as_float(rr[1]); }
    return v;
}
__device__ __forceinline__ float lx32(float x, bool h5) { auto rr = __builtin_amdgcn_permlane32_swap(__float_as_uint(x), __float_as_uint(x), false, false); return __uint_as_float(h5 ? rr[0] : rr[1]); }
__device__ __forceinline__ float lx16(float x, bool h4) { auto rr = __builtin_amdgcn_permlane16_swap(__float_as_uint(x), __float_as_uint(x), false, false); return __uint_as_float(h4 ? rr[0] : rr[1]); }
__device__ __forceinline__ float lx8(float x) { return __builtin_bit_cast(float, __builtin_amdgcn_update_dpp(0, __builtin_bit_cast(int, x), 0x128, 0xF, 0xF, true)); }
__device__ __forceinline__ float sum8_dpp(float v) {
    v += __builtin_bit_cast(float, __builtin_amdgcn_update_dpp(0, __builtin_bit_cast(int, v), 0xB1, 0xF, 0xF, true));
    v += __builtin_bit_cast(float, __builtin_amdgcn_update_dpp(0, __builtin_bit_cast(int, v), 0x4E, 0xF, 0xF, true));
    v += __builtin_bit_cast(float, __builtin_amdgcn_update_dpp(0, __builtin_bit_cast(int, v), 0x141, 0xF, 0xF, true));
    return v;
}
__device__ __forceinline__ void wave_sum4(float (&p)[4], int lane) {
    const bool h5 = (lane >> 5) & 1, h4 = (lane >> 4) & 1;
    float a0 = h5 ? p[2] : p[0], a1 = h5 ? p[3] : p[1]; const float b0 = h5 ? p[0] : p[2], b1 = h5 ? p[1] : p[3];
    a0 += lx32(b0, h5); a1 += lx32(b1, h5);
    float c = h4 ? a1 : a0; const float d = h4 ? a0 : a1; c += lx16(d, h4);
    c = sum8_dpp(c); c += __builtin_bit_cast(float, __builtin_amdgcn_update_dpp(0, __builtin_bit_cast(int, c), 0x140, 0xF, 0xF, true));
#pragma unroll
    for (int o = 0; o < 4; ++o) p[o] = __builtin_bit_cast(float, __builtin_amdgcn_readlane(__builtin_bit_cast(int, c), 32 * (o >> 1) + 16 * (o & 1)));
}
__device__ __forceinline__ void wave_sum8(float (&p)[8], int lane) {
    const bool h5 = (lane >> 5) & 1, h4 = (lane >> 4) & 1, h3 = (lane >> 3) & 1;
    float a[4];
#pragma unroll
    for (int i = 0; i < 4; ++i) { const float keep = h5 ? p[4 + i] : p[i], send = h5 ? p[i] : p[4 + i]; a[i] = keep + lx32(send, h5); }
    float b[2];
#pragma unroll
    for (int i = 0; i < 2; ++i) { const float keep = h4 ? a[2 + i] : a[i], send = h4 ? a[i] : a[2 + i]; b[i] = keep + lx16(send, h4); }
    float c = h3 ? b[1] : b[0]; const float d = h3 ? b[0] : b[1]; c += lx8(d);
    c = sum8_dpp(c);
#pragma unroll
    for (int o = 0; o < 8; ++o) p[o] = __builtin_bit_cast(float, __builtin_amdgcn_readlane(__builtin_bit_cast(int, c), 32 * (o >> 2) + 16 * ((o >> 1) & 1) + 8 * (o & 1)));
}
__device__ __forceinline__ int mod_sel(int row) { return row < MC ? 2 : ((row - MC) >> 14); }
__device__ __forceinline__ const float* mod_ptr(const unsigned char* ws, int layer, int sel, int part) { return (const float*)(ws + WS_SMALL + SM_MOD) + ((size_t)(layer * 3 + sel) * 6 + part) * DM; }

__device__ __forceinline__ void p0_transpose_item(const float* S, int ldS, int k0, int scol0, bf16* Dst, int ldD, int drow0, int dk0, bool perm, LAS float* scr, int lane) {
    float tv[32];
#pragma unroll
    for (int i = 0; i < 32; ++i) { const int kk = 2 * i + (lane >> 5); tv[i] = S[(size_t)(k0 + kk) * ldS + scol0 + (lane & 31)]; }
#pragma unroll
    for (int i = 0; i < 32; ++i) { const int kk = 2 * i + (lane >> 5); scr[kk * 33 + (lane & 31)] = tv[i]; }
    LDS_WAIT(); asm volatile("" ::: "memory");
    const int c = lane & 7;
#pragma unroll
    for (int j = 0; j < 4; ++j) { const int n = (lane >> 3) + 8 * j;
        int sn = n;
        if (perm) { const int p = (drow0 + n) & 63, i2 = p >> 1, odd = p & 1; const int dim = ((i2 < 16) ? i2 : i2 + 16) + 16 * odd; sn = dim & 31; }
        const LAS float* s = scr + (8 * c) * 33 + sn;
        u32x4 o; o.x = cvt_pk_bf16(s[0 * 33], s[1 * 33]); o.y = cvt_pk_bf16(s[2 * 33], s[3 * 33]); o.z = cvt_pk_bf16(s[4 * 33], s[5 * 33]); o.w = cvt_pk_bf16(s[6 * 33], s[7 * 33]);
        *(GAS u32x4*)(Dst + (size_t)(drow0 + n) * ldD + dk0 + 8 * c) = o; }
    LDS_WAIT(); asm volatile("" ::: "memory");
}
__device__ __forceinline__ void wg_transpose_item(Frame& F, const float* S, int ldS, int k0, int scol0, bf16* Dst, int ldD, int drow_base, int dk0, int mode) {
    LAS float* tile = (LAS float*)F.lds;
    f32x4 tv[8];
#pragma unroll
    for (int r = 0; r < 8; ++r) { const int k = F.wave + 8 * r; tv[r] = *(const f32x4*)(S + (size_t)(k0 + k) * ldS + scol0 + 4 * F.lane); }
#pragma unroll
    for (int r = 0; r < 8; ++r) { const int k = F.wave + 8 * r; *(LAS f32x4*)(tile + k * 256 + ((F.lane ^ ((k >> 3) & 7)) << 2)) = tv[r]; }
    __syncthreads();
    const int c = F.tid & 7, nn = F.tid >> 3;
#pragma unroll
    for (int jj = 0; jj < 4; ++jj) { const int j = nn + 64 * jj;
        int col = j;
        if (mode == 1) { const int p = j & 63, i2 = p >> 1, odd = p & 1; const int dim = ((i2 < 16) ? i2 : i2 + 16) + 16 * odd; col = (j & ~63) + dim; }
        const int drow = drow_base + ((mode == 2) ? ((j >> 7) * 256 + (j & 127)) : j);
        const LAS float* sp = tile + (8 * c) * 256 + (((col >> 2) ^ c) << 2) + (col & 3);
        u32x4 o; o.x = cvt_pk_bf16(sp[0 * 256], sp[1 * 256]); o.y = cvt_pk_bf16(sp[2 * 256], sp[3 * 256]); o.z = cvt_pk_bf16(sp[4 * 256], sp[5 * 256]); o.w = cvt_pk_bf16(sp[6 * 256], sp[7 * 256]);
        *(GAS u32x4*)(Dst + (size_t)drow * ldD + dk0 + 8 * c) = o; }
    __syncthreads();
}
__device__ __forceinline__ float silu_f(float x) { return x / (1.f + __expf(-x)); }
__device__ __forceinline__ void sincos_d(double x, double& s, double& c) {
    const double TWO_PI = 6.283185307179586476925286766559, INV = 0.15915494309189533576888376337251;
    double k = __builtin_rint(x * INV); double r = __builtin_fma(-k, TWO_PI, x);
    const double HALF_PI = 1.5707963267948966192313216916398;
    double q = __builtin_rint(r / HALF_PI); double y = r - q * HALF_PI; int qi = ((int)q) & 3;
    double y2 = y * y;
    double sp = y * (1.0 + y2 * (-1.0 / 6 + y2 * (1.0 / 120 + y2 * (-1.0 / 5040 + y2 * (1.0 / 362880 + y2 * (-1.0 / 39916800 + y2 * (1.0 / 6227020800.0 + y2 * (-1.0 / 1307674368000.0))))))));
    double cp = 1.0 + y2 * (-0.5 + y2 * (1.0 / 24 + y2 * (-1.0 / 720 + y2 * (1.0 / 40320 + y2 * (-1.0 / 3628800 + y2 * (1.0 / 479001600.0 + y2 * (-1.0 / 87178291200.0 + y2 * (1.0 / 20922789888000.0))))))));
    if (qi == 0) { s = sp; c = cp; } else if (qi == 1) { s = cp; c = -sp; } else if (qi == 2) { s = -sp; c = -cp; } else { s = -cp; c = sp; }
}

__device__ __forceinline__ void p0_prologue(Frame& F, ArgsP AP) {
    struct { const float* in[25]; } A;
#pragma unroll
    for (int i = 0; i < 25; ++i) A.in[i] = AP->in[i];
    unsigned char* ws = F.ws;
    {
        LAS float* sv = (LAS float*)(F.lds);
        LAS float* red = (LAS float*)(F.lds + 16384);
        for (int i = F.tid; i < 3 * DM; i += 512) { const int v = i >> 10, k = i & 1023; const float x = (v < 2) ? A.in[1][v * DM + k] : A.in[3][k]; sv[i] = silu_f(x); }
        __syncthreads();
        const int cidx = F.tid & 31, rg = F.tid >> 5;
        for (int it = F.c; it < NLAYER * 192; it += F.G) {
            const int l = it / 192, c0 = (it % 192) * 32;
            const float* W = A.in[4] + (size_t)l * DM * 6144 + c0 + cidx;
            float a0 = 0.f, a1 = 0.f, a2 = 0.f;
#pragma unroll
            for (int ib = 0; ib < 64; ib += 16) { float wv[16];
#pragma unroll
                for (int i = 0; i < 16; ++i) wv[i] = W[(size_t)(rg + 16 * (ib + i)) * 6144];
#pragma unroll
                for (int i = 0; i < 16; ++i) { const int r = rg + 16 * (ib + i); a0 += sv[r] * wv[i]; a1 += sv[1024 + r] * wv[i]; a2 += sv[2048 + r] * wv[i]; } }
            red[(rg * 3 + 0) * 32 + cidx] = a0; red[(rg * 3 + 1) * 32 + cidx] = a1; red[(rg * 3 + 2) * 32 + cidx] = a2;
            __syncthreads();
            if (F.tid < 96) { const int v = F.tid >> 5, cc = F.tid & 31; float s = 0.f;
#pragma unroll
                for (int q = 0; q < 16; ++q) s += red[(q * 3 + v) * 32 + cc];
                ((float*)(ws + WS_SMALL + SM_MOD))[(size_t)(l * 3 + v) * 6144 + c0 + cc] = s + A.in[5][l * 6144 + c0 + cc]; }
            __syncthreads();
        }
    }
    {
        constexpr int W_IN = 16 * 8, W_O = 8 * 4, W_GU = 32 * 2 * 16, W_D = 32 * 4 * 4, W_LAYER = W_IN + W_O + W_GU + W_D;
        for (int it0 = F.c; it0 < NLAYER * W_LAYER; it0 += F.G) {
            const int l = it0 / W_LAYER; int r = it0 % W_LAYER;
            if (r < W_IN) { const int kb = r / 8, nb = r % 8;
                wg_transpose_item(F, A.in[8] + (size_t)l * DM * DIN, DIN, kb * 64, nb * 256, (bf16*)(ws + WS_WIN) + (size_t)l * DIN * DM, DM, nb * 256, kb * 64, (nb >= 2 && nb < 6) ? 1 : 0); continue; } r -= W_IN;
            if (r < W_O) { const int kb = r / 4, nb = r % 4;
                wg_transpose_item(F, A.in[16] + (size_t)l * DM * DM + (size_t)512 * DM, DM, kb * 64, nb * 256, (bf16*)(ws + WS_W2) + (size_t)l * DM * DM, DM, nb * 256, 512 + kb * 64, 0); continue; } r -= W_O;
            if (r < W_GU) { const int e = r / 32, q = r % 32, hb = q / 16, kb = q % 16;
                const float* src = (hb ? A.in[22] : A.in[21]) + ((size_t)l * NEXP + e) * DM * DEXP;
                wg_transpose_item(F, src, DEXP, kb * 64, 0, (bf16*)(ws + WS_WGU) + ((size_t)l * NEXP + e) * 512 * DM, DM, hb * 128, kb * 64, 2); continue; } r -= W_GU;
            { const int e = r / 16, q = r % 16, kb = q / 4, nb = q % 4;
                wg_transpose_item(F, A.in[23] + ((size_t)l * NEXP + e) * DEXP * DM, DM, kb * 64, nb * 256, (bf16*)(ws + WS_WD) + ((size_t)l * NEXP + e) * DM * DEXP, DEXP, nb * 256, kb * 64, 0); }
        }
    }
    const int gw = F.c * 8 + F.wave, NGW = F.G * 8;
    constexpr int I_F = 4 * 16 * 8;
    for (int it0 = gw; it0 < NLAYER * I_F + 64 + 1; it0 += NGW) {
        if (it0 >= NLAYER * I_F) {
            const int x = it0 - NLAYER * I_F;
            if (x < 64) {
                const int idx = x * 64 + F.lane, pos = idx >> 4, f = idx & 15;
                const double inv[16] = {1.0, 0.56234132519034908039, 0.31622776601683793320, 0.17782794100389228012, 0.1, 0.056234132519034908039, 0.031622776601683793320, 0.017782794100389228012,
                                        0.01, 0.0056234132519034908039, 0.0031622776601683793320, 0.0017782794100389228012, 0.001, 0.00056234132519034908039, 0.00031622776601683793320, 0.00017782794100389228012};
                double invf = inv[0];
#pragma unroll
                for (int q = 1; q < 16; ++q) invf = (f == q) ? inv[q] : invf;
                double s, c; sincos_d((double)pos * invf, s, c);
                ((f32x2*)(ws + WS_SMALL + SM_ROPE))[idx] = (f32x2){(float)c, (float)s};
            } else {
                for (int l = 0; l < NLAYER; ++l) {
                    const float d1 = wave_sum(A.in[11][l * 64 + F.lane] * A.in[12][l * 64 + F.lane]);
                    const float d2 = wave_sum(A.in[13][l * 64 + F.lane] * A.in[14][l * 64 + F.lane]);
                    const float lam_init = 0.8f - 0.6f * expf(-0.3f * (float)l);
                    if (F.lane == 0) ((float*)(ws + WS_SMALL + SM_LAM))[l] = expf(d1) - expf(d2) + lam_init;
                }
            }
            continue;
        }
        const int l = it0 / I_F; const int r = it0 % I_F;
        {
            const int g = r / 128, q = r % 128, nb = q / 8, kb = q % 8, n = nb * 64 + F.lane, kk0 = kb * 16;
            const float* pw = A.in[9] + ((size_t)(l * 4 + g) * 128 + kk0) * 128; const float* ps = A.in[10] + l * 512 + g * 128;
            const float* wo = A.in[16] + (size_t)l * DM * DM + (size_t)(g * 128) * DM + n;
            float acc[16];
#pragma unroll
            for (int k = 0; k < 16; ++k) acc[k] = 0.f;
            for (int jb = 0; jb < 128; jb += 16) { float wv[16];
#pragma unroll
                for (int j = 0; j < 16; ++j) wv[j] = wo[(size_t)(jb + j) * DM];
#pragma unroll
                for (int j = 0; j < 16; ++j) { const float w = wv[j] * ps[jb + j];
#pragma unroll
                    for (int k = 0; k < 16; ++k) acc[k] += pw[k * 128 + jb + j] * w; } }
            u32x4 o0, o1; o0.x = cvt_pk_bf16(acc[0], acc[1]); o0.y = cvt_pk_bf16(acc[2], acc[3]); o0.z = cvt_pk_bf16(acc[4], acc[5]); o0.w = cvt_pk_bf16(acc[6], acc[7]);
            o1.x = cvt_pk_bf16(acc[8], acc[9]); o1.y = cvt_pk_bf16(acc[10], acc[11]); o1.z = cvt_pk_bf16(acc[12], acc[13]); o1.w = cvt_pk_bf16(acc[14], acc[15]);
            bf16* d = (bf16*)(ws + WS_W2) + (size_t)l * DM * DM + (size_t)n * DM + g * 128 + kk0;
            *(GAS u32x4*)d = o0; *(GAS u32x4*)(d + 8) = o1;
        }
    }
}

__device__ __forceinline__ const float* src_row0(ArgsP A, int row) { return row < MC ? A->in[2] + (size_t)row * DM : A->in[0] + (size_t)(row - MC) * DM; }
__device__ __forceinline__ void norm_mod_store(const f32x4 (&v)[4], const float* gain, const float* sh, const float* sc, bf16* orow, int lane) {
    f32x4 mg[4], m1[4], m0[4];
#pragma unroll
    for (int j = 0; j < 4; ++j) { const int c = 4 * lane + 256 * j; mg[j] = *(const f32x4*)(gain + c); m1[j] = *(const f32x4*)(sc + c); m0[j] = *(const f32x4*)(sh + c); }
    float ss = 0.f;
#pragma unroll
    for (int j = 0; j < 4; ++j) ss += (v[j].x * v[j].x + v[j].y * v[j].y) + (v[j].z * v[j].z + v[j].w * v[j].w);
    const float rstd = 1.f / sqrtf(wave_sum(ss) * (1.f / DM) + EPS);
#pragma unroll
    for (int j = 0; j < 4; ++j) { const int c = 4 * lane + 256 * j;
        const f32x4 y = (v[j] * rstd) * mg[j] * (m1[j] + 1.f) + m0[j];
        u32x2 o; o.x = cvt_pk_bf16(y.x, y.y); o.y = cvt_pk_bf16(y.z, y.w); *(GAS u32x2*)(orow + c) = o; }
}
__device__ __forceinline__ void phase_norm1_first(Frame& F, ArgsP A) {
    const int gw = F.c * 8 + F.wave, NGW = F.G * 8; bf16* HX = (bf16*)(F.ws + WS_HX);
    for (int m = gw; m < MT; m += NGW) {
        const float* xr = src_row0(A, m); f32x4 v[4];
#pragma unroll
        for (int j = 0; j < 4; ++j) v[j] = *(const f32x4*)(xr + 4 * F.lane + 256 * j);
        const int sel = mod_sel(m);
        norm_mod_store(v, A->in[6], mod_ptr(F.ws, 0, sel, 0), mod_ptr(F.ws, 0, sel, 1), HX + (size_t)m * DM, F.lane);
    }
}
template <bool DRY> __device__ __forceinline__ void phase_combine(Frame& F, ArgsP A, int l) {
    const int gw = F.c * 8 + F.wave, NGW = F.G * 8; bf16* HX = (bf16*)(F.ws + WS_HX); bf16* X = (bf16*)(F.ws + WS_X); const bf16* Y = (const bf16*)(F.ws + WS_U);
    const bool lastl = (l == NLAYER - 1);
    for (int m = gw + (lastl ? MC : 0); m < MT; m += NGW) {
        bf16* xr = X + (size_t)m * DM; f32x4 v[4]; const int sel = mod_sel(m); const float* g2 = mod_ptr(F.ws, l, sel, 5);
#pragma unroll
        for (int j = 0; j < 4; ++j) { const int c = 4 * F.lane + 256 * j; { const u32x2 q = *(const GAS u32x2*)(xr + c); v[j] = (f32x4){bf2f(q.x & 0xffffu), bf2f(q.x >> 16), bf2f(q.y & 0xffffu), bf2f(q.y >> 16)}; }
            const u32x2 y0 = *(const GAS u32x2*)(Y + (size_t)(2 * m) * DM + c), y1 = *(const GAS u32x2*)(Y + (size_t)(2 * m + 1) * DM + c);
            f32x4 ys; ys.x = bf2f(y0.x & 0xffffu) + bf2f(y1.x & 0xffffu); ys.y = bf2f(y0.x >> 16) + bf2f(y1.x >> 16); ys.z = bf2f(y0.y & 0xffffu) + bf2f(y1.y & 0xffffu); ys.w = bf2f(y0.y >> 16) + bf2f(y1.y >> 16);
            v[j] = v[j] + *(const f32x4*)(g2 + c) * ys; }
        if (!lastl) {
            if (!DRY) {
#pragma unroll
            for (int j = 0; j < 4; ++j) { u32x2 o; o.x = cvt_pk_bf16(v[j].x, v[j].y); o.y = cvt_pk_bf16(v[j].z, v[j].w); *(GAS u32x2*)(xr + 4 * F.lane + 256 * j) = o; } }
            norm_mod_store(v, A->in[6] + (l + 1) * DM, mod_ptr(F.ws, l + 1, sel, 0), mod_ptr(F.ws, l + 1, sel, 1), HX + (size_t)m * DM, F.lane);
        } else {
            float ss = 0.f;
#pragma unroll
            for (int j = 0; j < 4; ++j) ss += (v[j].x * v[j].x + v[j].y * v[j].y) + (v[j].z * v[j].z + v[j].w * v[j].w);
            const float rstd = 1.f / sqrtf(wave_sum(ss) * (1.f / DM) + EPS);
            float* orow = A->out + (size_t)(m - MC) * DM; const float* fg = A->in[24];
#pragma unroll
            for (int j = 0; j < 4; ++j) { const int c = 4 * F.lane + 256 * j; *(f32x4*)(orow + c) = (v[j] * rstd) * *(const f32x4*)(fg + c); }
        }
    }
}
template <bool DRY> __device__ __forceinline__ void phase_norm2_route(Frame& F, ArgsP A, int l) {
    const float* rcw = A->in[17]; const float* rcb = A->in[18]; const float* rfw = A->in[19]; const float* rfb = A->in[20]; const float* n2g = A->in[7];
    LAS float* wl = (LAS float*)F.lds;
    for (int k = F.tid; k < DM; k += 512) { const f32x4 w = *(const f32x4*)(rcw + (size_t)l * DM * 4 + k * 4);
        wl[0 * DM + k] = w.x; wl[1 * DM + k] = w.y; wl[2 * DM + k] = w.z; wl[3 * DM + k] = w.w; }
    for (int q = F.tid; q < DM * 8; q += 512) { const int k = q >> 3, o4 = q & 7; const f32x4 w = *(const f32x4*)(rfw + (size_t)l * DM * 32 + k * 32 + 4 * o4);
        wl[(4 + 4 * o4 + 0) * DM + k] = w.x; wl[(4 + 4 * o4 + 1) * DM + k] = w.y; wl[(4 + 4 * o4 + 2) * DM + k] = w.z; wl[(4 + 4 * o4 + 3) * DM + k] = w.w; }
    LAS unsigned* rt_e = (LAS unsigned*)(F.lds + RT_OFF);
    LAS unsigned* rt_p0 = rt_e + 256; LAS unsigned* rt_p1 = rt_p0 + 256; LAS float* rt_w0 = (LAS float*)(rt_p1 + 256); LAS float* rt_w1 = rt_w0 + 256;
    LAS unsigned* cl = (LAS unsigned*)(rt_w1 + 256); LAS unsigned* basev = cl + 32;
    if (F.tid < 32) cl[F.tid] = 0u;
    __syncthreads();
    const int mlo = (l == NLAYER - 1) ? MC : 0, nrows = MT - mlo, per = (nrows + F.G - 1) / F.G;
    const int r0 = mlo + F.c * per, r1 = (r0 + per < MT) ? r0 + per : MT;
    bf16* HX = (bf16*)(F.ws + WS_HX); const bf16* X = (const bf16*)(F.ws + WS_X);
    float bc[4];
#pragma unroll
    for (int o = 0; o < 4; ++o) bc[o] = rcb[l * 4 + o];
    for (int m = r0 + F.wave; m < r1; m += 8) {
        const bf16* xr = X + (size_t)m * DM; f32x4 v[4]; float ss = 0.f; u32x2 xv[4];
#pragma unroll
        for (int j = 0; j < 4; ++j) xv[j] = *(const GAS u32x2*)(xr + 4 * F.lane + 256 * j);
#pragma unroll
        for (int j = 0; j < 4; ++j) { v[j] = (f32x4){bf2f(xv[j].x & 0xffffu), bf2f(xv[j].x >> 16), bf2f(xv[j].y & 0xffffu), bf2f(xv[j].y >> 16)};
            ss += (v[j].x * v[j].x + v[j].y * v[j].y) + (v[j].z * v[j].z + v[j].w * v[j].w); }
        const float rstd = 1.f / sqrtf(wave_sum(ss) * (1.f / DM) + EPS);
        const int sel = mod_sel(m); const float* gain = n2g + l * DM; const float* sh = mod_ptr(F.ws, l, sel, 3); const float* sc = mod_ptr(F.ws, l, sel, 4);
        bf16* orow = HX + (size_t)m * DM;
#pragma unroll
        for (int j = 0; j < 4; ++j) { const int c = 4 * F.lane + 256 * j;
            const f32x4 g = *(const f32x4*)(gain + c), s1 = *(const f32x4*)(sc + c), s0 = *(const f32x4*)(sh + c);
            v[j] = (v[j] * rstd) * g * (s1 + 1.f) + s0;
            u32x2 o; o.x = cvt_pk_bf16(v[j].x, v[j].y); o.y = cvt_pk_bf16(v[j].z, v[j].w); *(GAS u32x2*)(orow + c) = o; }
        float lc[4];
#pragma unroll
        for (int o = 0; o < 4; ++o) { f32x2 p2 = {0.f, 0.f};
#pragma unroll
            for (int j = 0; j < 4; ++j) { const f32x4 w = *(const LAS f32x4*)(wl + o * DM + 4 * F.lane + 256 * j);
                p2 = __builtin_elementwise_fma(__builtin_shufflevector(v[j], v[j], 0, 1), __builtin_shufflevector(w, w, 0, 1), p2);
                p2 = __builtin_elementwise_fma(__builtin_shufflevector(v[j], v[j], 2, 3), __builtin_shufflevector(w, w, 2, 3), p2); }
            lc[o] = p2.x + p2.y; }
        wave_sum4(lc, F.lane);
#pragma unroll
        for (int o = 0; o < 4; ++o) lc[o] += bc[o];
        int g = 0; float best = lc[0];
#pragma unroll
        for (int o = 1; o < 4; ++o) if (lc[o] > best) { best = lc[o]; g = o; }
        float den = 0.f;
#pragma unroll
        for (int o = 0; o < 4; ++o) den += __expf(lc[o] - best);
        const float pg = __builtin_amdgcn_rcpf(den);
        float lf[8];
#pragma unroll
        for (int o = 0; o < 8; ++o) { f32x2 p2 = {0.f, 0.f}; const LAS float* wrow = wl + (4 + g * 8 + o) * DM;
#pragma unroll
            for (int j = 0; j < 4; ++j) { const f32x4 w = *(const LAS f32x4*)(wrow + 4 * F.lane + 256 * j);
                p2 = __builtin_elementwise_fma(__builtin_shufflevector(v[j], v[j], 0, 1), __builtin_shufflevector(w, w, 0, 1), p2);
                p2 = __builtin_elementwise_fma(__builtin_shufflevector(v[j], v[j], 2, 3), __builtin_shufflevector(w, w, 2, 3), p2); }
            lf[o] = p2.x + p2.y; }
        wave_sum8(lf, F.lane);
#pragma unroll
        for (int o = 0; o < 8; ++o) lf[o] += rfb[l * 32 + g * 8 + o];
        int i0 = 0; float v0 = lf[0];
#pragma unroll
        for (int o = 1; o < 8; ++o) if (lf[o] > v0) { v0 = lf[o]; i0 = o; }
        int i1 = -1; float v1 = -3.0e38f;
#pragma unroll
        for (int o = 0; o < 8; ++o) if (o != i0 && lf[o] > v1) { v1 = lf[o]; i1 = o; }
        const float ex = __expf(v1 - v0); const float rq = pg * __builtin_amdgcn_rcpf(1.f + ex); const float w0 = rq, w1 = rq * ex;
        if (F.lane == 0) { const int e0 = g * 8 + i0, e1 = g * 8 + i1, lr = m - r0;
            rt_e[lr] = (unsigned)e0 | ((unsigned)e1 << 8); rt_w0[lr] = w0; rt_w1[lr] = w1;
            rt_p0[lr] = __hip_atomic_fetch_add(cl + e0, 1u, __ATOMIC_RELAXED, __HIP_MEMORY_SCOPE_WORKGROUP);
            rt_p1[lr] = __hip_atomic_fetch_add(cl + e1, 1u, __ATOMIC_RELAXED, __HIP_MEMORY_SCOPE_WORKGROUP); }
    }
    __syncthreads();
    if (DRY) { __syncthreads(); return; }
    if (F.tid < 32) basev[F.tid] = __hip_atomic_fetch_add((unsigned*)(F.ctl + CW_CNT + (l * 32 + F.tid) * 64), cl[F.tid], RLX_AGENT);
    __syncthreads();
    unsigned* LIST = (unsigned*)(F.ws + WS_LIST); float* GWT = (float*)(F.ws + WS_GW);
    for (int lr = F.tid; lr < r1 - r0; lr += 512) { const unsigned ee = rt_e[lr]; const int e0 = ee & 255, e1 = (ee >> 8) & 255, m = r0 + lr;
        const unsigned p0 = basev[e0] + rt_p0[lr], p1 = basev[e1] + rt_p1[lr];
        LIST[(size_t)e0 * CAP + p0] = 2u * m; GWT[(size_t)e0 * CAP + p0] = rt_w0[lr];
        LIST[(size_t)e1 * CAP + p1] = 2u * m + 1u; GWT[(size_t)e1 * CAP + p1] = rt_w1[lr]; }
    __syncthreads();
}

struct EpiQKV {
    bf16* U; const f32x2* rope; unsigned* kmax;
    __device__ __forceinline__ void operator()(const f32x4 (&acc)[2][2][4][2], const pg8::Unit& u, int wr, int wc, int fr, int fq) const {
        const int typ = u.pn >> 1;
        bf16* base = U + (size_t)typ * (SZ_QKV / 2);
        const int cb = (u.pn & 1) * 256 + wc * 32 + 8 * fq;
        float kh[2] = {0.f, 0.f};
#pragma unroll
        for (int ai = 0; ai < 2; ++ai)
#pragma unroll
            for (int m = 0; m < 4; ++m) {
                const int row = u.pm * 256 + ai * 128 + wr * 64 + m * 16 + fr;
                const bool lat = row >= MC; const int t = (row - MC) & (SEQ - 1);
#pragma unroll
                for (int bj = 0; bj < 2; ++bj) {
                    const int c = cb + bj * 128;
                    f32x4 v0 = acc[ai][bj][m][0], v1 = acc[ai][bj][m][1];
                    if (typ == 1 || typ == 2) {
                        if (lat) {
                            const int i0 = (c & 63) >> 1, axis = i0 >> 4, f0 = i0 & 15, pos = axis ? (t & (GRIDW - 1)) : (t >> 6);
                            const f32x4 cs0 = *(const f32x4*)(rope + pos * 16 + f0), cs1 = *(const f32x4*)(rope + pos * 16 + f0 + 2);
                            f32x4 r0, r1;
                            r0.x = v0.x * cs0.x - v0.y * cs0.y; r0.y = v0.y * cs0.x + v0.x * cs0.y; r0.z = v0.z * cs0.z - v0.w * cs0.w; r0.w = v0.w * cs0.z + v0.z * cs0.w;
                            r1.x = v1.x * cs1.x - v1.y * cs1.y; r1.y = v1.y * cs1.x + v1.x * cs1.y; r1.z = v1.z * cs1.z - v1.w * cs1.w; r1.w = v1.w * cs1.z + v1.z * cs1.w;
                            v0 = r0; v1 = r1;
                        }
                        if (typ == 1) { v0 = v0 * QSCALE; v1 = v1 * QSCALE; }
                    }
                    u32x4 w; w.x = cvt_pk_bf16(v0.x, v0.y); w.y = cvt_pk_bf16(v0.z, v0.w); w.z = cvt_pk_bf16(v1.x, v1.y); w.w = cvt_pk_bf16(v1.z, v1.w);
                    *(GAS u32x4*)(base + (size_t)row * 512 + c) = w;
                    if (typ == 2) { float hs = (v0.x * v0.x + v0.y * v0.y) + (v0.z * v0.z + v0.w * v0.w) + (v1.x * v1.x + v1.y * v1.y) + (v1.z * v1.z + v1.w * v1.w);
                        hs += __shfl_xor(hs, 16); hs += __shfl_xor(hs, 32); kh[bj] = fmaxf(kh[bj], hs); }
                }
            }
        if (typ == 2) {
            const int b = (u.pm == 0) ? 0 : (u.pm == 1) ? 1 : ((u.pm - 2) >> 6);
#pragma unroll
            for (int bj = 0; bj < 2; ++bj) { float x = kh[bj];
#pragma unroll
                for (int o = 1; o < 16; o <<= 1) x = fmaxf(x, __shfl_xor(x, o));
                if (fr == 0 && fq == 0) atomicMax(kmax + ((b * 4 + (u.pn & 1) * 2 + bj) * 2 + (wc >> 1)) * 64, __float_as_uint(x)); }
        }
    }
};
struct EpiRes {
    const float* ctx0; const float* x0; const unsigned char* ws; bf16* X; int layer, row_off; bool dry;
    __device__ __forceinline__ void operator()(const f32x4 (&acc)[2][2][4][2], const pg8::Unit& u, int wr, int wc, int fr, int fq) const {
        const int rowt = row_off + u.pm * 256; const int sel = mod_sel(rowt); const float* g1 = mod_ptr(ws, layer, sel, 2);
        const int c0 = u.pn * 256 + wc * 32 + 8 * fq;
        f32x4 gv[2][2];
#pragma unroll
        for (int bj = 0; bj < 2; ++bj)
#pragma unroll
            for (int n = 0; n < 2; ++n) gv[bj][n] = *(const f32x4*)(g1 + c0 + bj * 128 + 4 * n);
#pragma unroll
        for (int ai = 0; ai < 2; ++ai)
#pragma unroll
            for (int m = 0; m < 4; ++m) {
                const int row = rowt + ai * 128 + wr * 64 + m * 16 + fr;
#pragma unroll
                for (int bj = 0; bj < 2; ++bj) { const int c = c0 + bj * 128; f32x4 r0, r1;
                    if (layer == 0) { const float* res = (row < MC ? ctx0 + (size_t)row * DM : x0 + (size_t)(row - MC) * DM) + c; r0 = *(const f32x4*)res; r1 = *(const f32x4*)(res + 4); }
                    else { const u32x4 q = *(const GAS u32x4*)(X + (size_t)row * DM + c);
                        r0 = (f32x4){bf2f(q.x & 0xffffu), bf2f(q.x >> 16), bf2f(q.y & 0xffffu), bf2f(q.y >> 16)}; r1 = (f32x4){bf2f(q.z & 0xffffu), bf2f(q.z >> 16), bf2f(q.w & 0xffffu), bf2f(q.w >> 16)}; }
                    const f32x4 v0 = r0 + gv[bj][0] * acc[ai][bj][m][0], v1 = r1 + gv[bj][1] * acc[ai][bj][m][1];
                    u32x4 w; w.x = cvt_pk_bf16(v0.x, v0.y); w.y = cvt_pk_bf16(v0.z, v0.w); w.z = cvt_pk_bf16(v1.x, v1.y); w.w = cvt_pk_bf16(v1.z, v1.w);
                    if (!dry) *(GAS u32x4*)(X + (size_t)row * DM + c) = w; }
            }
    }
};
struct EpiGateUp {
    bf16* HID; const volatile LAS float* ulgw;
    __device__ __forceinline__ void operator()(const f32x4 (&acc)[2][2][4][2], const pg8::Unit& u, int wr, int wc, int fr, int fq) const {
        const int pn = u.pn & 1, c0 = pn * 128 + wc * 32 + 8 * fq;
#pragma unroll
        for (int ai = 0; ai < 2; ++ai)
#pragma unroll
            for (int m = 0; m < 4; ++m) {
                const int lr = ai * 128 + wr * 64 + m * 16 + fr; const float gw = ulgw[u.ui * 256 + lr];
                float h[8];
#pragma unroll
                for (int n = 0; n < 2; ++n)
#pragma unroll
                    for (int j = 0; j < 4; ++j) { const float a = acc[ai][0][m][n][j], b = acc[ai][1][m][n][j];
                        const float s = a * __builtin_amdgcn_rcpf(1.f + __builtin_amdgcn_exp2f(-1.4426950408889634f * a)); h[n * 4 + j] = s * b * gw; }
                u32x4 w; w.x = cvt_pk_bf16(h[0], h[1]); w.y = cvt_pk_bf16(h[2], h[3]); w.z = cvt_pk_bf16(h[4], h[5]); w.w = cvt_pk_bf16(h[6], h[7]);
                *(GAS u32x4*)(HID + ((size_t)u.pm * 256 + lr) * DEXP + c0) = w;
            }
    }
};
struct EpiDown {
    bf16* Y; bf16* dummy; const volatile LAS unsigned* ultok;
    __device__ __forceinline__ void operator()(const f32x4 (&acc)[2][2][4][2], const pg8::Unit& u, int wr, int wc, int fr, int fq) const {
        const int pn = u.pn & 3, c0 = pn * 256 + wc * 32 + 8 * fq;
#pragma unroll
        for (int ai = 0; ai < 2; ++ai)
#pragma unroll
            for (int m = 0; m < 4; ++m) {
                const int lr = ai * 128 + wr * 64 + m * 16 + fr; const unsigned tk = ultok[u.ui * 256 + lr];
                bf16* dst = (tk == 0xFFFFFFFFu ? dummy : Y + (size_t)tk * DM) + c0;
#pragma unroll
                for (int bj = 0; bj < 2; ++bj) { const f32x4 v0 = acc[ai][bj][m][0], v1 = acc[ai][bj][m][1];
                    u32x4 w; w.x = cvt_pk_bf16(v0.x, v0.y); w.y = cvt_pk_bf16(v0.z, v0.w); w.z = cvt_pk_bf16(v1.x, v1.y); w.w = cvt_pk_bf16(v1.z, v1.w);
                    *(GAS u32x4*)(dst + bj * 128) = w; }
            }
    }
};
__device__ __forceinline__ void moe_setup(Frame& F, int l, int ntn) {
    volatile LAS unsigned* P = F.MISC + 16; volatile LAS unsigned* C = F.MISC + 64; volatile LAS int* T = (volatile LAS int*)(F.MISC + 128);
    if (F.tid < 32) C[F.tid] = __hip_atomic_load((unsigned*)(F.ctl + CW_CNT + (l * 32 + F.tid) * 64), RLX_AGENT);
    __syncthreads();
    if (F.tid == 0) { unsigned s = 0; for (int e = 0; e < 32; ++e) { P[e] = s; s += (C[e] + 255u) >> 8; } P[32] = s;
        int n = 0;
        for (int i = 0; i < 6; ++i) { const int L = i * F.G + F.c; if (L >= (int)s * ntn) break; const int gb = L / ntn, pn = L % ntn; int e = 0;
            for (int k = 1; k < 32; ++k) e = ((int)P[k] <= gb) ? k : e;
            T[2 + 2 * i] = gb; T[3 + 2 * i] = e * ntn + pn; T[16 + 2 * i] = e; T[17 + 2 * i] = gb - (int)P[e]; n = i + 1; }
        T[0] = n; }
    __syncthreads();
    volatile LAS unsigned* ultok = (volatile LAS unsigned*)(F.lds + UL_OFF); volatile LAS float* ulgw = (volatile LAS float*)(F.lds + UL_OFF + 6144);
    const unsigned* LIST = (const unsigned*)(F.ws + WS_LIST); const float* GWT = (const float*)(F.ws + WS_GW);
    const int nu = T[0];
    for (int i = 0; i < nu; ++i) { const int e = T[16 + 2 * i], lb = T[17 + 2 * i], cnt = (int)C[e];
        if (F.tid < 256) { const int pos = lb * 256 + F.tid; const bool ok = pos < cnt;
            ultok[i * 256 + F.tid] = ok ? LIST[(size_t)e * CAP + pos] : 0xFFFFFFFFu; ulgw[i * 256 + F.tid] = ok ? GWT[(size_t)e * CAP + pos] : 0.f; } }
    __syncthreads();
}

__device__ __forceinline__ void phase_pool(Frame& F) {
    const bf16* U = (const bf16*)(F.ws + WS_U); bf16* AO = (bf16*)(F.ws + WS_HX);
    const int cg = F.tid & 63, rs = F.tid >> 6, g = cg >> 4, w = 2 << g, left = w >> 1, right = w - 1 - left;
    LAS unsigned char* tile = F.lds;
#define ACC8(S, X, OP) do { S[0] OP bf2f(X.x & 0xffffu); S[1] OP bf2f(X.x >> 16); S[2] OP bf2f(X.y & 0xffffu); S[3] OP bf2f(X.y >> 16); S[4] OP bf2f(X.z & 0xffffu); S[5] OP bf2f(X.z >> 16); S[6] OP bf2f(X.w & 0xffffu); S[7] OP bf2f(X.w >> 16); } while (0)
    for (int blk = F.c; blk < MT / 64; blk += F.G) {
        const int rowb = blk * 64;
        const int seq0 = rowb < MC ? (rowb & ~(NCTX - 1)) : MC + ((rowb - MC) & ~(SEQ - 1)); const int n = rowb < MC ? NCTX : SEQ;
        const int tb = rowb - seq0; int lo = tb - 8; lo = lo < 0 ? 0 : lo; int hi = tb + 64 + 7; hi = hi > n ? n : hi;
        const int nchunk = (hi - lo) * 64;
        const bf16* Us = U + (size_t)(seq0 + lo) * 512;
        __syncthreads();
        u32x4 st[10];
#pragma unroll
        for (int i = 0; i < 10; ++i) { const int c = F.tid + i * 512; if (c < nchunk) st[i] = *(const GAS u32x4*)(Us + (size_t)c * 8); }
#pragma unroll
        for (int i = 0; i < 10; ++i) { const int c = F.tid + i * 512; if (c < nchunk) *(LAS u32x4*)(tile + c * 16) = st[i]; }
        __syncthreads();
        const LAS unsigned char* col = tile + cg * 16 - lo * 1024;
        const int t0 = tb + rs * 8;
        float s[8];
#pragma unroll
        for (int k = 0; k < 8; ++k) s[k] = 0.f;
        int l0 = t0 - left; l0 = l0 < 0 ? 0 : l0; int h0 = t0 + right + 1; h0 = h0 > n ? n : h0;
        for (int i = l0; i < h0; ++i) { const u32x4 x = *(const LAS u32x4*)(col + i * 1024); ACC8(s, x, +=); }
#pragma unroll
        for (int k = 0; k < 8; ++k) {
            const int t = t0 + k;
            if (k > 0) {
                const int add = t + right, sub = t - 1 - left;
                if (add < n) { const u32x4 x = *(const LAS u32x4*)(col + add * 1024); ACC8(s, x, +=); }
                if (sub >= 0) { const u32x4 x = *(const LAS u32x4*)(col + sub * 1024); ACC8(s, x, -=); }
            }
            int l2 = t - left; l2 = l2 < 0 ? 0 : l2; int h2 = t + right + 1; h2 = h2 > n ? n : h2; const float ic = 1.f / (float)(h2 - l2);
            const u32x4 x = *(const LAS u32x4*)(col + t * 1024);
            u32x4 o; o.x = cvt_pk_bf16(s[0] * ic - bf2f(x.x & 0xffffu), s[1] * ic - bf2f(x.x >> 16)); o.y = cvt_pk_bf16(s[2] * ic - bf2f(x.y & 0xffffu), s[3] * ic - bf2f(x.y >> 16));
            o.z = cvt_pk_bf16(s[4] * ic - bf2f(x.z & 0xffffu), s[5] * ic - bf2f(x.z >> 16)); o.w = cvt_pk_bf16(s[6] * ic - bf2f(x.w & 0xffffu), s[7] * ic - bf2f(x.w >> 16));
            *(GAS u32x4*)(AO + (size_t)(seq0 + t) * DM + cg * 8) = o;
        }
    }
#undef ACC8
    __syncthreads();
}

namespace dattn {
constexpr int KVBLK = 64;
#define SBAR() __builtin_amdgcn_sched_barrier(0)
__device__ __forceinline__ int crow(int r, int hi) { return (r & 3) + 8 * (r >> 2) + 4 * hi; }
typedef __bf16 bf16x2_t __attribute__((ext_vector_type(2))); typedef short v4i16_t __attribute__((ext_vector_type(4)));
__device__ __forceinline__ unsigned cvtpk(float lo, float hi) { f32x2 v = {lo, hi}; bf16x2_t b = __builtin_convertvector(v, bf16x2_t); return __builtin_bit_cast(unsigned, b); }
constexpr int RING = 3, SLOTB = 16384, K_RING = 0, V_RING = RING * SLOTB, LDS_WSCR3 = 2 * RING * SLOTB;
#define WAITBAR(N) asm volatile("s_waitcnt vmcnt(" #N ")\n\ts_barrier" ::: "memory")
typedef LAS const char* lds_cptr;
__device__ __forceinline__ s16x4 vtr(lds_cptr p) { return __builtin_bit_cast(s16x4, __builtin_amdgcn_ds_read_tr16_b64_v4i16((LAS v4i16_t*)p)); }
__device__ __forceinline__ void attn_unit_v4(const bf16* __restrict__ Qg, const bf16* __restrict__ Kg, const bf16* __restrict__ Vg, int seg0, int nt0, int seg1, int NT,
                                             bf16* AOg, float lam, const float* subg, float post, float kmax_s0, float kmax_s1, LAS unsigned char* ldsl, char* lds) {
  const int tid = threadIdx.x, wid = __builtin_amdgcn_readfirstlane(tid >> 6), lane = tid & 63, r32 = lane & 31, hi = lane >> 5, sub = wid >> 2, qb = wid & 3;
  float* wsf = (float*)(lds + LDS_WSCR3) + wid * 64; float* li_l = wsf;
  float l_reg = 0; f32x16 o[4] = {}; bf16x8 qr[4];
  const bf16* Qw = Qg + (size_t)(qb * 32 + r32) * 512 + sub * 64 + hi * 8;
#pragma unroll
  for (int d0 = 0; d0 < 4; ++d0) qr[d0] = *reinterpret_cast<const bf16x8*>(Qw + d0 * 16);
  f32x16 cin;
  { float qs = 0.f;
#pragma unroll
    for (int d0 = 0; d0 < 4; ++d0)
#pragma unroll
      for (int e = 0; e < 8; ++e) { const float x = bf2f((unsigned)(unsigned short)qr[d0][e]); qs += x * x; }
    { auto rr = __builtin_amdgcn_permlane32_swap(__float_as_uint(qs), __float_as_uint(qs), false, false); qs = __uint_as_float(rr[0]) + __uint_as_float(rr[1]); }
    const float c = -fmaxf(0.f, 1.01f * sqrtf(qs * 2.f * (sub ? kmax_s1 : kmax_s0)) - 60.f);
#pragma unroll
    for (int r = 0; r < 16; ++r) cin[r] = c; }
  const unsigned koff = (unsigned)(lane * 512 + wid * 8);
  const int vst = 2 * wid + (lane >> 5), vy = lane & 31, vk = (vst >> 2) * 8 + (vy >> 2);
  const unsigned voff = (unsigned)(vk * 512 + (vst & 3) * 32 + (vy & 3) * 8);
  const unsigned pieceoff = (unsigned)wid * 1024u;
  const lds_cptr kp0 = (lds_cptr)ldsl + K_RING + (sub * 8 + hi) * 1024 + r32 * 16;
  const lds_cptr vp0 = (lds_cptr)ldsl + V_RING + ((lane >> 4) & 1) * 32 + (lane & 3) * 8 + (4 * hi + ((lane & 15) >> 2)) * 64;
#define TROW(j) ((j) < nt0 ? seg0 + (j) * 64 : seg1 + ((j) - nt0) * 64)
#define DMA16(gp, loff) __builtin_amdgcn_global_load_lds((const unsigned*)(gp), (LAS unsigned*)(ldsl + (loff)), 16, 0, 0)
#define ISSUE_K(t, slot) do { const int _t = (t) < NT ? (t) : NT - 1; const bf16* _p = Kg + (size_t)TROW(_t) * 512 + koff; const unsigned _l = K_RING + (slot) * SLOTB + pieceoff; DMA16(_p, _l); DMA16(_p + 64, _l + 8192u); } while (0)
#define ISSUE_V(t, slot) do { const int _t = (t) < NT ? (t) : NT - 1; const bf16* _p = Vg + (size_t)TROW(_t) * 512 + voff; const unsigned _l = V_RING + (slot) * SLOTB + pieceoff; DMA16(_p, _l); DMA16(_p + 32 * 512, _l + 8192u); } while (0)
#define NEXT3(m) ((m) == 2 ? 0 : (m) + 1)
#define PIN(x) asm volatile("" : "+v"(x))
#define EX(v) __builtin_amdgcn_exp2f(v)
#define PKW(P, B) cvtpk(P[B], P[(B) + 1])
#define PAF(k) __builtin_bit_cast(bf16x8, pw##k)
#define KRD(f) (*(const LAS bf16x8*)(kp_ + ((f) >> 1) * 2048 + ((f) & 1) * 512))
#define KLDA(f) asm volatile("ds_read_b128 %0, %1 offset:%2" : "=v"(ka) : "v"(kad_), "i"(((f) >> 1) * 2048 + ((f) & 1) * 512))
#define KLDB(f) asm volatile("ds_read_b128 %0, %1 offset:%2" : "=v"(kb) : "v"(kad_), "i"(((f) >> 1) * 2048 + ((f) & 1) * 512))
#define KLDC(f) asm volatile("ds_read_b128 %0, %1 offset:%2" : "=v"(kc) : "v"(kad_), "i"(((f) >> 1) * 2048 + ((f) & 1) * 512))
#define VLDA(i) do { asm volatile("ds_read_b64_tr_b16 %0, %1 offset:%2" : "=v"(vlo[(i) % 3]) : "v"(vad_), "i"(((i) & 3) * 512 + ((i) >> 2) * 4096)); \
                     asm volatile("ds_read_b64_tr_b16 %0, %1 offset:%2" : "=v"(vhi[(i) % 3]) : "v"(vad_), "i"(((i) & 3) * 512 + ((i) >> 2) * 4096 + 2048)); } while (0)
#define LWAITM(N) asm volatile("s_waitcnt lgkmcnt(" #N ")" ::: "memory")
#define VRD(i) do { vlo[(i) % 3] = vtr(vp_ + ((i) & 3) * 512 + ((i) >> 2) * 4096); vhi[(i) % 3] = vtr(vp_ + ((i) & 3) * 512 + ((i) >> 2) * 4096 + 2048); } while (0)
#define VFR(i) (bf16x8){vlo[(i) % 3][0], vlo[(i) % 3][1], vlo[(i) % 3][2], vlo[(i) % 3][3], vhi[(i) % 3][0], vhi[(i) % 3][1], vhi[(i) % 3][2], vhi[(i) % 3][3]}
#define MF(a, b, c) __builtin_amdgcn_mfma_f32_32x32x16_bf16(a, b, c, 0, 0, 0)
#define GAPA(NW, MFX, NEXTK, A0, A1, A2, A3, W0, W1, PW) do { LWAITM(NW); SBAR(); MFX; SBAR(); NEXTK; sacc += A0; sacc2 += A1; sacc += A2; sacc2 += A3; PIN(sacc); PIN(sacc2); W0; W1; PIN(PW); SBAR(); } while (0)
#define GAPB(NW, i, X, B, XTRA) do { LWAITM(NW); SBAR(); o[(i) & 3] = MF(PAF_SEL((i) >> 2), VFR(i), o[(i) & 3]); SBAR(); if ((i) + 2 < 16) VLDA((i) + 2); XTRA; X[B] = EX(X[B]); X[(B) + 1] = EX(X[(B) + 1]); PIN(X); SBAR(); } while (0)
#define PAF_SEL(k) ((k) == 0 ? PAF(0) : (k) == 1 ? PAF(1) : (k) == 2 ? PAF(2) : PAF(3))
#define STEP(C0, C1, P0, P1, ks_, vs_, tk_, sk_, tv_, sv_) do { SBAR(); \
    const unsigned kad_ = kbase + (unsigned)(ks_) * SLOTB, vad_ = vbase + (unsigned)(vs_) * SLOTB; \
    const bf16* kgp_ = Kg + (size_t)TROW(((tk_) < NT ? (tk_) : NT - 1)) * 512 + koff; const bf16* vgp_ = Vg + (size_t)TROW(((tv_) < NT ? (tv_) : NT - 1)) * 512 + voff; \
    const unsigned kl_ = K_RING + (sk_) * SLOTB + pieceoff, vl_ = V_RING + (sv_) * SLOTB + pieceoff; \
    bf16x8 ka, kb, kc; KLDA(0); KLDB(1); KLDC(2); float sacc = P0[0], sacc2 = P0[1]; SBAR(); \
    LWAITM(2); SBAR(); C0 = MF(ka, qr[0], cin); SBAR(); KLDA(3); SBAR(); \
    LWAITM(2); SBAR(); C1 = MF(kb, qr[0], cin); SBAR(); KLDB(4); SBAR(); \
    LWAITM(2); SBAR(); C0 = MF(kc, qr[1], C0); SBAR(); KLDC(5); sacc += P0[2]; sacc2 += P0[3]; sacc += P0[4]; sacc2 += P0[5]; sacc += P0[6]; PIN(sacc); PIN(sacc2); pw0[0] = PKW(P0, 0); pw0[1] = PKW(P0, 2); pw0[2] = PKW(P0, 4); PIN(pw0); SBAR(); \
    LWAITM(2); SBAR(); C1 = MF(ka, qr[1], C1); SBAR(); KLDA(6); sacc2 += P0[7]; sacc += P0[8]; sacc2 += P0[9]; sacc += P0[10]; sacc2 += P0[11]; PIN(sacc); PIN(sacc2); pw0[3] = PKW(P0, 6); pw1[0] = PKW(P0, 8); pw1[1] = PKW(P0, 10); PIN(pw0); PIN(pw1); SBAR(); \
    LWAITM(2); SBAR(); C0 = MF(kb, qr[2], C0); SBAR(); KLDB(7); sacc += P0[12]; sacc2 += P0[13]; sacc += P0[14]; sacc2 += P0[15]; sacc += P1[0]; PIN(sacc); PIN(sacc2); pw1[2] = PKW(P0, 12); pw1[3] = PKW(P0, 14); pw2[0] = PKW(P1, 0); PIN(pw1); PIN(pw2); SBAR(); \
    LWAITM(2); SBAR(); C1 = MF(kc, qr[2], C1); SBAR(); ; sacc2 += P1[1]; sacc += P1[2]; sacc2 += P1[3]; sacc += P1[4]; sacc2 += P1[5]; PIN(sacc); PIN(sacc2); pw2[1] = PKW(P1, 2); pw2[2] = PKW(P1, 4); pw2[3] = PKW(P1, 6); PIN(pw2); SBAR(); \
    LWAITM(1); SBAR(); C0 = MF(ka, qr[3], C0); SBAR(); VLDA(0); sacc += P1[6]; sacc2 += P1[7]; sacc += P1[8]; sacc2 += P1[9]; sacc += P1[10]; PIN(sacc); PIN(sacc2); pw3[0] = PKW(P1, 8); pw3[1] = PKW(P1, 10); PIN(pw3); SBAR(); \
    LWAITM(2); SBAR(); C1 = MF(kb, qr[3], C1); SBAR(); VLDA(1); sacc2 += P1[11]; sacc += P1[12]; sacc2 += P1[13]; sacc += P1[14]; sacc2 += P1[15]; PIN(sacc); PIN(sacc2); pw3[2] = PKW(P1, 12); pw3[3] = PKW(P1, 14); PIN(pw3); SBAR(); \
    l_reg += sacc + sacc2; \
    GAPB(2, 0, C0, 0, );  GAPB(2, 1, C0, 2, );  GAPB(2, 2, C0, 4, DMA16(kgp_, kl_));   GAPB(2, 3, C0, 6, );   GAPB(2, 4, C0, 8, );   GAPB(2, 5, C0, 10, );  GAPB(2, 6, C0, 12, DMA16(kgp_ + 64, kl_ + 8192u));  GAPB(2, 7, C0, 14, ); \
    GAPB(2, 8, C1, 0, );  GAPB(2, 9, C1, 2, );  GAPB(2, 10, C1, 4, DMA16(vgp_, vl_));  GAPB(2, 11, C1, 6, );  GAPB(2, 12, C1, 8, );  GAPB(2, 13, C1, 10, ); GAPB(2, 14, C1, 12, DMA16(vgp_ + 32 * 512, vl_ + 8192u)); GAPB(0, 15, C1, 14, ); \
  } while (0)
  f32x16 pA0, pA1, pB0, pB1; u32x4 pw0, pw1, pw2, pw3; s16x4 vlo[3], vhi[3];
  const unsigned kbase = (unsigned)(__UINTPTR_TYPE__)kp0, vbase = (unsigned)(__UINTPTR_TYPE__)vp0;
  if (wid >= 4) __builtin_amdgcn_s_setprio(1);
  ISSUE_K(0, 0); ISSUE_K(1, 1); ISSUE_V(0, 0);
  WAITBAR(4);
  ISSUE_K(2, 2); ISSUE_V(1, 1);
  { const lds_cptr kp_ = kp0;
    pA0 = MF(KRD(0), qr[0], cin); pA1 = MF(KRD(1), qr[0], cin); pA0 = MF(KRD(2), qr[1], pA0); pA1 = MF(KRD(3), qr[1], pA1);
    pA0 = MF(KRD(4), qr[2], pA0); pA1 = MF(KRD(5), qr[2], pA1); pA0 = MF(KRD(6), qr[3], pA0); pA1 = MF(KRD(7), qr[3], pA1);
#pragma unroll
    for (int r = 0; r < 16; ++r) { pA0[r] = EX(pA0[r]); pA1[r] = EX(pA1[r]); } }
  int m = 1;
  for (int t = 1; t + 1 < NT; t += 2) {
    const int m1 = NEXT3(m), m2 = NEXT3(m1);
    WAITBAR(4);
    STEP(pB0, pB1, pA0, pA1, m, m2, t + 2, m2, t + 1, m1);
    WAITBAR(4);
    STEP(pA0, pA1, pB0, pB1, m1, m, t + 3, m, t + 2, m2);
    m = m2;
  }
  { const int m2 = (m == 0) ? 2 : m - 1;
    WAITBAR(4);
    STEP(pB0, pB1, pA0, pA1, m, m2, NT, m2, NT, NEXT3(m));
    WAITBAR(0);
    { float sacc = 0.f;
#pragma unroll
      for (int r = 0; r < 16; ++r) sacc += pB0[r] + pB1[r];
      l_reg += sacc; }
    pw0 = (u32x4){PKW(pB0, 0), PKW(pB0, 2), PKW(pB0, 4), PKW(pB0, 6)}; pw1 = (u32x4){PKW(pB0, 8), PKW(pB0, 10), PKW(pB0, 12), PKW(pB0, 14)};
    pw2 = (u32x4){PKW(pB1, 0), PKW(pB1, 2), PKW(pB1, 4), PKW(pB1, 6)}; pw3 = (u32x4){PKW(pB1, 8), PKW(pB1, 10), PKW(pB1, 12), PKW(pB1, 14)};
    const lds_cptr vp_ = vp0 + m * SLOTB;
#pragma unroll
    for (int i = 0; i < 16; ++i) { const s16x4 a = vtr(vp_ + (i & 3) * 512 + (i >> 2) * 4096), b = vtr(vp_ + (i & 3) * 512 + (i >> 2) * 4096 + 2048);
      o[i & 3] = MF(PAF_SEL(i >> 2), ((bf16x8){a[0], a[1], a[2], a[3], b[0], b[1], b[2], b[3]}), o[i & 3]); } }
  __builtin_amdgcn_s_setprio(0);
  asm volatile("s_waitcnt vmcnt(0) lgkmcnt(0)" ::: "memory");
  __syncthreads();
  float* E = (float*)lds;
  { auto rr = __builtin_amdgcn_permlane32_swap(__float_as_uint(l_reg), __float_as_uint(l_reg), false, false); l_reg = __uint_as_float(rr[0]) + __uint_as_float(rr[1]); }
  if (hi == 0) li_l[r32] = l_reg; asm volatile("s_waitcnt lgkmcnt(0)" ::: "memory");
  float rli[16];
#pragma unroll
  for (int r = 0; r < 16; ++r) rli[r] = __builtin_amdgcn_rcpf(li_l[crow(r, hi)]);
  if (sub == 1) {
#pragma unroll
    for (int r = 0; r < 16; ++r)
#pragma unroll
      for (int d0 = 0; d0 < 4; ++d0) E[(qb * 32 + crow(r, hi)) * 128 + d0 * 32 + r32] = o[d0][r] * rli[r] * lam;
  }
  __syncthreads();
  if (sub == 0) {
#pragma unroll
    for (int r = 0; r < 16; ++r)
#pragma unroll
      for (int d0 = 0; d0 < 4; ++d0) { const int idx = (qb * 32 + crow(r, hi)) * 128 + d0 * 32 + r32; E[idx] = o[d0][r] * rli[r] - E[idx]; }
    asm volatile("s_waitcnt lgkmcnt(0)" ::: "memory");
    const float* rowp = E + (qb * 32 + r32) * 128 + hi * 64;
    f32x4 vals[16]; float ss = 0.f;
#pragma unroll
    for (int q = 0; q < 16; ++q) { vals[q] = *(const f32x4*)(rowp + 4 * q); ss += (vals[q].x * vals[q].x + vals[q].y * vals[q].y) + (vals[q].z * vals[q].z + vals[q].w * vals[q].w); }
    { auto rr = __builtin_amdgcn_permlane32_swap(__float_as_uint(ss), __float_as_uint(ss), false, false); ss = __uint_as_float(rr[0]) + __uint_as_float(rr[1]); }
    const float rstd = post / sqrtf(ss * (1.f / 128.f) + EPS);
    bf16* orow = AOg + (size_t)(qb * 32 + r32) * DM + hi * 64;
#pragma unroll
    for (int q = 0; q < 8; ++q) { const f32x4 a = vals[2 * q], b = vals[2 * q + 1]; const f32x4 ga = *(const f32x4*)(subg + hi * 64 + 8 * q), gb = *(const f32x4*)(subg + hi * 64 + 8 * q + 4);
      u32x4 w; w.x = cvtpk(a.x * rstd * ga.x, a.y * rstd * ga.y); w.y = cvtpk(a.z * rstd * ga.z, a.w * rstd * ga.w); w.z = cvtpk(b.x * rstd * gb.x, b.y * rstd * gb.y); w.w = cvtpk(b.z * rstd * gb.z, b.w * rstd * gb.w);
      *(u32x4*)(orow + 8 * q) = w; }
  }
  asm volatile("s_waitcnt vmcnt(0)" ::: "memory");
  __syncthreads();
#undef TROW
#undef DMA16
#undef ISSUE_K
#undef ISSUE_V
#undef NEXT3
#undef PIN
#undef EX
#undef PKW
#undef PAF
#undef KRD
#undef VRD
#undef VFR
#undef MF
#undef GAPA
#undef GAPB
#undef PAF_SEL
#undef STEP
}
}

__device__ __forceinline__ void phase_attention(Frame& F, ArgsP A, int l, char* lds) {
    const bf16* Q = (const bf16*)(F.ws + WS_U + SZ_QKV); const bf16* K = (const bf16*)(F.ws + WS_U + 2 * SZ_QKV); const bf16* V = (const bf16*)(F.ws + WS_U + 3 * SZ_QKV);
    bf16* AO = (bf16*)(F.ws + WS_HX);
    const float lam = ((const float*)(F.ws + WS_SMALL + SM_LAM))[l]; const float post = 1.f - (0.8f - 0.6f * expf(-0.3f * (float)l));
    const float* subg = A->in[15] + l * 128;
#define KMAXV(b, h, sb) __builtin_bit_cast(float, __hip_atomic_load((unsigned*)(F.ctl + CW_KMAX + ((l * 2 + (b)) * 8 + (h) * 2 + (sb)) * 64), RLX_AGENT))
    if (l == 0) {
        for (int u = F.c; u < 16; u += F.G) { const int bh = u & 7, qb = u >> 3, b = bh >> 2, h = bh & 3, row0 = b * NCTX + qb * 128;
            dattn::attn_unit_v4(Q + (size_t)row0 * 512 + h * 128, K + h * 128, V + h * 128, b * NCTX, 4, 0, 4, AO + (size_t)row0 * DM + 512 + h * 128, lam, subg, post, KMAXV(b, h, 0), KMAXV(b, h, 1), F.lds, lds); }
    }
    { const int x0 = (int)(xb_xcc_id() & 7u);
      volatile LAS int* tk = (volatile LAS int*)(F.MISC + 200);
      for (int k = 0; k < 8; ++k) { const int bh = (x0 + k) & 7, b = bh >> 2, h = bh & 3;
        for (;;) {
          __syncthreads();
          if (F.tid == 0) tk[0] = (int)__hip_atomic_fetch_add((unsigned*)(F.ctl + CW_TICK + (l * 8 + bh) * 64), 1u, RLX_AGENT);
          __syncthreads();
          const int qb = __builtin_amdgcn_readfirstlane(tk[0]);
          if (qb >= 128) break;
          const int row0 = MC + b * SEQ + qb * 128;
          dattn::attn_unit_v4(Q + (size_t)row0 * 512 + h * 128, K + h * 128, V + h * 128, MC + b * SEQ, SEQ / 64, b * NCTX, SEQ / 64 + NCTX / 64, AO + (size_t)row0 * DM + 512 + h * 128, lam, subg, post, KMAXV(b, h, 0), KMAXV(b, h, 1), F.lds, lds); } } }
#undef KMAXV
}

__global__ void __launch_bounds__(512, 2) fwd_kernel(Args args_unused) {
    ArgsP args = (ArgsP)__builtin_amdgcn_kernarg_segment_ptr();
    extern __shared__ __attribute__((aligned(16))) unsigned char lds[];
    Frame F;
    F.lds = (LAS unsigned char*)lds; F.MISC = (volatile LAS unsigned*)(F.lds + MISC_OFF);
    F.tid = threadIdx.x; F.lane = F.tid & 63; F.wave = __builtin_amdgcn_readfirstlane(F.tid >> 6);
    F.G = gridDim.x; F.c = blockIdx.x; F.ws = args->ws; F.ctl = (gu32*)(F.ws + WS_CTL);
    for (int u = F.tid; u < 256; u += 512) F.MISC[u] = 0u;
    __syncthreads();
#if MK_PER_PHASE || DBG_CHECK
    XcdBarrier bar; bar.bar = (unsigned*)(F.ctl + CW_BAR); bar.x = 0; bar.st = nullptr;
#define GRID_BAR() do { } while (0)
#else
    XcdBarrier bar = xcd_barrier_post((unsigned*)(F.ctl + CW_BAR), F.MISC + 8);
#define GRID_BAR() xcd_barrier(bar)
#endif
    const int lo = args->ph_lo, hi = args->ph_hi;
#ifndef KMASK
#define KMASK 0x1ff
#endif
#define KON(k) (((KMASK) >> (k)) & 1)
#ifndef REP_MASK
#define REP_MASK 0
#endif
#define NREP(k) (1 + (((REP_MASK) >> (k)) & 1))
#define IN(k) (lo <= (k) && (k) < hi)
#define SEAM(k) do { if (IN((k) + 1)) { GRID_BAR(); if (NREP(10) == 2) { GRID_BAR(); GRID_BAR(); GRID_BAR(); GRID_BAR(); } } } while (0)
    if (KON(0) && IN(0)) { if (NREP(0) == 2) { p0_prologue(F, args); GRID_BAR(); } p0_prologue(F, args); SEAM(0); }
    if (KON(1) && IN(1)) { if (NREP(1) == 2) { phase_norm1_first(F, args); GRID_BAR(); } phase_norm1_first(F, args); SEAM(1); }
#define PH_G1(l) do { \
            pg8::Gemm g{(const bf16*)(F.ws + WS_HX), (const bf16*)(F.ws + WS_WIN) + (size_t)l * DIN * DM, MT, DIN, DM}; pg8::StaticOrder S; S.init(MT, DIN, F.G, F.c); \
            EpiQKV E{(bf16*)(F.ws + WS_U), (const f32x2*)(F.ws + WS_SMALL + SM_ROPE), (unsigned*)(F.ctl + CW_KMAX + l * 16 * 64)}; \
            pg8::gemm_phase<EpiQKV, pg8::StaticOrder, true, false>(F.lds, g, S, E); } while (0)
#define PH_G2(l, DRYRUN) do { \
            const int roff = (l == NLAYER - 1) ? MC : 0; \
            pg8::Gemm g{(const bf16*)(F.ws + WS_HX) + (size_t)roff * DM, (const bf16*)(F.ws + WS_W2) + (size_t)l * DM * DM, MT - roff, DM, DM}; pg8::StaticOrder S; S.init(MT - roff, DM, F.G, F.c); \
            EpiRes E{args->in[2], args->in[0], F.ws, (bf16*)(F.ws + WS_X), l, roff, DRYRUN}; \
            pg8::gemm_phase<EpiRes, pg8::StaticOrder, true, false>(F.lds, g, S, E); } while (0)
#define PH_MA(l) do { \
            moe_setup(F, l, 2); \
            pg8::Gemm g{(const bf16*)(F.ws + WS_HX), (const bf16*)(F.ws + WS_WGU) + (size_t)l * NEXP * 512 * DM, 0, 0, DM}; \
            pg8::MoeOrder S{(const volatile LAS int*)(F.MISC + 128)}; \
            EpiGateUp E{(bf16*)(F.ws + WS_HID), (const volatile LAS float*)(F.lds + UL_OFF + 6144)}; \
            pg8::gemm_phase<EpiGateUp, pg8::MoeOrder, true, true>(F.lds, g, S, E); } while (0)
#define PH_MB(l) do { \
            moe_setup(F, l, 4); \
            pg8::Gemm g{(const bf16*)(F.ws + WS_HID), (const bf16*)(F.ws + WS_WD) + (size_t)l * NEXP * DM * DEXP, 0, 0, DEXP}; \
            pg8::MoeOrder S{(const volatile LAS int*)(F.MISC + 128)}; \
            EpiDown E{(bf16*)(F.ws + WS_U), (bf16*)(F.ws + WS_SMALL + SM_DUMMY), (const volatile LAS unsigned*)(F.lds + UL_OFF)}; \
            pg8::gemm_phase<EpiDown, pg8::MoeOrder, true, false>(F.lds, g, S, E); } while (0)
#define LAYER_BODY(l) do { \
        const int pb = 2 + 7 * l; \
        if (KON(2) && IN(pb + 0)) { if (NREP(2) == 2) { PH_G1(l); GRID_BAR(); } PH_G1(l); SEAM(pb + 0); } \
        if (KON(3) && IN(pb + 1)) { if (NREP(9) == 2) phase_pool(F); phase_pool(F); if (NREP(3) == 2) { phase_attention(F, args, l, (char*)lds); GRID_BAR(); } phase_attention(F, args, l, (char*)lds); SEAM(pb + 1); } \
        if (KON(4) && IN(pb + 2)) { if (NREP(4) == 2 && l == 0) { PH_G2(l, false); GRID_BAR(); } PH_G2(l, false); SEAM(pb + 2); } \
        if (KON(5) && IN(pb + 3)) { if (NREP(5) == 2) { phase_norm2_route<true>(F, args, l); GRID_BAR(); } phase_norm2_route<false>(F, args, l); SEAM(pb + 3); } \
        if (KON(6) && IN(pb + 4)) { if (NREP(6) == 2) { PH_MA(l); GRID_BAR(); } PH_MA(l); SEAM(pb + 4); } \
        if (KON(7) && IN(pb + 5)) { if (NREP(7) == 2) { PH_MB(l); GRID_BAR(); } PH_MB(l); SEAM(pb + 5); } \
        if (KON(8) && IN(pb + 6)) { if (NREP(8) == 2) { phase_combine<true>(F, args, l); GRID_BAR(); } phase_combine<false>(F, args, l); SEAM(pb + 6); } \
    } while (0)
    LAYER_BODY(0);
    LAYER_BODY(1);
#undef LAYER_BODY
#undef PH_G1
#undef PH_G2
#undef PH_MA
#undef PH_MB
#if !(MK_PER_PHASE || DBG_CHECK)
    if (hi == NPH) {
        if (__hip_atomic_load((unsigned*)(F.ctl + CW_BAR) + XB_TMO, RLX_AGENT) != 0u) {
            __syncthreads(); const float q = __builtin_nanf("");
            for (size_t i = (size_t)F.c * 512 + F.tid; i < (size_t)ML * DM; i += (size_t)F.G * 512) args->out[i] = q; }
    }
#endif
#undef IN
#undef SEAM
}

extern "C" void kernel_launch(void* const* d_in, const int* in_sizes, int n_in, void* d_out, int out_size, void* d_ws, size_t ws_size, hipStream_t stream) {
    static int grid = 0;
    if (grid == 0) {
        if (n_in != 25 || in_sizes[0] != ML * DM || out_size != ML * DM || ws_size < WS_END) { fprintf(stderr, "kernel_launch: shape/workspace mismatch (n_in %d, in0 %d, out %d, ws %zu < %zu)\n", n_in, n_in > 0 ? in_sizes[0] : -1, out_size, ws_size, (size_t)WS_END); grid = -1; return; }
        int dev = 0, cus = 0, per_cu = 0;
        if (hipGetDevice(&dev) != hipSuccess || hipDeviceGetAttribute(&cus, hipDeviceAttributeMultiprocessorCount, dev) != hipSuccess) { grid = -1; return; }
        if (hipFuncSetAttribute((const void*)fwd_kernel, hipFuncAttributeMaxDynamicSharedMemorySize, LDS_BYTES) != hipSuccess) { fprintf(stderr, "kernel_launch: hipFuncSetAttribute failed\n"); grid = -1; return; }
        if (hipOccupancyMaxActiveBlocksPerMultiprocessor(&per_cu, (const void*)fwd_kernel, 512, LDS_BYTES) != hipSuccess || per_cu < 1) { fprintf(stderr, "kernel_launch: occupancy query says %d\n", per_cu); }
        (void)hipGetLastError();
        grid = cus;
    }
    if (grid < 0) return;
    (void)hipMemsetAsync((char*)d_ws + WS_CTL, 0, CTL_ZERO_BYTES, stream);
    Args a{};
    for (int i = 0; i < 25; ++i) a.in[i] = (const float*)d_in[i];
    a.out = (float*)d_out; a.ws = (unsigned char*)d_ws;
#if MK_PER_PHASE || DBG_CHECK
    for (int p = 0; p < NPH; ++p) { a.ph_lo = p; a.ph_hi = p + 1; hipLaunchKernelGGL(fwd_kernel, dim3(grid), dim3(512), LDS_BYTES, stream, a); }
#else
    a.ph_lo = 0; a.ph_hi = NPH; hipLaunchKernelGGL(fwd_kernel, dim3(grid), dim3(512), LDS_BYTES, stream, a);
#endif
}
```

```cpp
#include <hip/hip_runtime.h>
#include <cstdio>
#include <cstdint>

#ifndef MK_PER_PHASE
#define MK_PER_PHASE 0
#endif
#ifndef DBG_CHECK
#define DBG_CHECK 0
#endif

#define GAS __attribute__((address_space(1)))
#define LAS __attribute__((address_space(3)))
typedef unsigned short bf16;
typedef unsigned u32x4 __attribute__((ext_vector_type(4)));
typedef unsigned u32x2 __attribute__((ext_vector_type(2)));
typedef float f32x4 __attribute__((ext_vector_type(4)));
typedef float f32x2 __attribute__((ext_vector_type(2)));
typedef float f32x16 __attribute__((ext_vector_type(16)));
typedef short bf16x8 __attribute__((ext_vector_type(8)));
typedef short s16x4 __attribute__((ext_vector_type(4)));
typedef GAS unsigned gu32;

constexpr int DM = 1024, NB = 2, SEQ = 16384, NCTX = 256, MC = NB * NCTX, ML = NB * SEQ, MT = MC + ML;
constexpr int DIN = 2048, DPOOL = 512, NH = 4, HD = 64, HV = 128, NEXP = 32, DEXP = 256, NLAYER = 2, GRIDW = 64;
constexpr float EPS = 1e-6f;
constexpr float QSCALE = 0.125f * 1.4426950408889634f;
constexpr int CAP = MT;
constexpr int NPH = 2 + 7 * NLAYER;

constexpr size_t MiB = 1u << 20;
constexpr size_t WS_CTL = 0, CTL_ZERO_BYTES = 1 * MiB;
constexpr size_t WS_SMALL = 1 * MiB;
constexpr size_t SM_MOD = 0, SM_ROPE = 163840, SM_LAM = 200704, SM_DUMMY = 262144;
constexpr size_t WS_WIN = 2 * MiB, WS_W2 = 10 * MiB, WS_WGU = 14 * MiB, WS_WD = 78 * MiB;
constexpr size_t WS_X = 110 * MiB;
constexpr size_t WS_HX = 240 * MiB;
constexpr size_t WS_U = 305 * MiB;
constexpr size_t SZ_QKV = (size_t)MT * 512 * 2;
constexpr size_t WS_HID = 435 * MiB;
constexpr size_t WS_LIST = 472 * MiB, WS_GW = 477 * MiB, WS_END = 482 * MiB;
constexpr int CW_TMO = 0, CW_CODE = 1, CW_BAR = 4096, CW_CNT = 16384  , CW_DBG = 32768;
constexpr int CW_TICK = 30720;
constexpr int CW_KMAX = 24576;

constexpr int RING_BYTES = 131072;
constexpr int UL_OFF = 131072;
constexpr int MISC_OFF = 147456;
constexpr int RT_OFF = MISC_OFF + 1024;
constexpr int LDS_BYTES = 155648;

__device__ __forceinline__ float bf2f(unsigned b) { return __builtin_bit_cast(float, b << 16); }
__device__ __forceinline__ unsigned cvt_pk_bf16(float lo, float hi) { unsigned r; asm volatile("v_cvt_pk_bf16_f32 %0, %1, %2" : "=v"(r) : "v"(lo), "v"(hi)); return r; }
#define LDS_WAIT() asm volatile("s_waitcnt lgkmcnt(0)" ::: "memory")
#define VM_WAIT() asm volatile("s_waitcnt vmcnt(0)" ::: "memory")
#define RLX_AGENT __ATOMIC_RELAXED, __HIP_MEMORY_SCOPE_AGENT

namespace pg8 {
constexpr int BM = 256, BK = 64, HALF = 128, HTB = HALF * BK * 2, STAGE_BYTES = 8 * HTB, NXCD = 8, WGM = 8;
__host__ __device__ __forceinline__ int lds_byte(int r, int c) { const int st = (r >> 4) * 2 + (c >> 5), rr = r & 15, cc = c & 31, ob = rr * 64 + cc * 2; return st * 1024 + (ob ^ (((ob >> 9) & 1) << 5)); }
__host__ __device__ __forceinline__ void stage_rc(int b, int& R, int& C) { const int st = b / 1024, sb = b % 1024, swz = sb ^ (((sb >> 9) & 1) << 5); R = (st >> 1) * 16 + swz / 64; C = (st & 1) * 32 + (swz % 64) / 2; }
__host__ __device__ __forceinline__ int perm32(int rho) { const int n = rho >> 4, i = rho & 15; return 8 * (i >> 2) + 4 * n + (i & 3); }

struct Unit { int pm, pn, ui; };
struct Gemm { const bf16* A; const bf16* Bt; int M, N, K; };

struct StaticOrder {
    int nM, nN, nwg, G, c;
    __device__ void init(int M, int N, int G_, int c_) { nM = M / BM; nN = N / BM; nwg = nM * nN; G = G_; c = c_; }
    __device__ bool next(int i, Unit& u) const {
        const long L = (long)i * G + c; if (L >= nwg) return false;
        int wgid = (int)L; { const int q = nwg / NXCD, r = nwg % NXCD, xcd = wgid % NXCD, off = wgid / NXCD; wgid = (xcd < r ? xcd * (q + 1) : r * (q + 1) + (xcd - r) * q) + off; }
        const int nig = WGM * nN, gid = wgid / nig, fm = gid * WGM, gsz = (nM - fm) < WGM ? (nM - fm) : WGM;
        u.pm = fm + ((wgid % nig) % gsz); u.pn = (wgid % nig) / gsz; u.ui = i; return true;
    }
};
struct MoeOrder {
    const volatile LAS int* T;
    __device__ bool next(int i, Unit& u) const {
        if (i >= __builtin_amdgcn_readfirstlane(T[0])) return false;
        u.pm = __builtin_amdgcn_readfirstlane(T[2 + 2 * i]); u.pn = __builtin_amdgcn_readfirstlane(T[3 + 2 * i]); u.ui = i; return true;
    }
};

template <class Epi, class Sched, bool ALIGN_EPI, bool GATHER>
__device__ __forceinline__ void gemm_phase(LAS unsigned char* lds, const Gemm g, const Sched& S, const Epi& E) {
    const int tid = threadIdx.x, wid = __builtin_amdgcn_readfirstlane(tid >> 6), lane = tid & 63, wr = wid >> 2, wc = wid & 3, fr = lane & 15, fq = lane >> 4;
    const int K = g.K, nt = K / BK;
    unsigned voffA[2], voffB[2];
#pragma unroll
    for (int i = 0; i < 2; ++i) { int R, C; stage_rc(tid * 16 + i * 8192, R, C); const int Rb = (R & ~31) + perm32(R & 31);
        voffA[i] = (unsigned)(R * K + C) * 2u; voffB[i] = (unsigned)(Rb * K + C) * 2u; }
    const size_t kstep = (size_t)(BK * 2);
    const size_t hstep = (size_t)HALF * K * 2;
    const size_t tstep = 2 * hstep;
    const unsigned ldsw = (unsigned)wid * 1024u;
    const int aoff = lds_byte(wr * 64 + fr, fq * 8), boff = lds_byte(wc * 32 + fr, fq * 8);
    const volatile LAS unsigned* ultok = (const volatile LAS unsigned*)(lds + UL_OFF);
#define PG8_SA(b, h) (((b) * 2 + (h)) * HTB)
#define PG8_SB(b, h) ((4 + (b) * 2 + (h)) * HTB)
#define PG8_STAGE(bufoff, gbase, voff) do { _Pragma("unroll") for (int _i = 0; _i < 2; ++_i) \
        __builtin_amdgcn_global_load_lds((const unsigned*)((const char*)(gbase) + (voff)[_i]), (LAS unsigned*)(lds + (bufoff) + ldsw + _i * 8192), 16, 0, 0); } while (0)
#define PG8_STA(bufoff, ptr, h, OFFS) do { if constexpr (GATHER) { PG8_STAGE(bufoff, ptr, OFFS[h]); } else { PG8_STAGE(bufoff, (ptr) + (h) * hstep, voffA); } } while (0)
#define PG8_GOFF(dst, U) do { _Pragma("unroll") for (int _h = 0; _h < 2; ++_h) _Pragma("unroll") for (int _i = 0; _i < 2; ++_i) { int _R, _C; stage_rc(tid * 16 + _i * 8192, _R, _C); \
        const unsigned _t = ultok[(U).ui * 256 + _h * 128 + _R]; const unsigned _row = (_t == 0xFFFFFFFFu) ? 0u : (_t >> 1); dst[_h][_i] = _row * (unsigned)(K * 2) + (unsigned)_C * 2u; } } while (0)
#define PG8_LDA(dst, b, h) do { _Pragma("unroll") for (int m = 0; m < 4; ++m) _Pragma("unroll") for (int k = 0; k < 2; ++k) dst[m][k] = *(const LAS bf16x8*)(lds + PG8_SA(b, h) + aoff + m * 2048 + k * 1024); } while (0)
#define PG8_LDB(dst, b, h) do { _Pragma("unroll") for (int n = 0; n < 2; ++n) _Pragma("unroll") for (int k = 0; k < 2; ++k) dst[n][k] = *(const LAS bf16x8*)(lds + PG8_SB(b, h) + boff + n * 2048 + k * 1024); } while (0)
#define PG8_MMA(ai, bj, At, Bt) do { __builtin_amdgcn_s_setprio(1); _Pragma("unroll") for (int m = 0; m < 4; ++m) _Pragma("unroll") for (int n = 0; n < 2; ++n) _Pragma("unroll") for (int k = 0; k < 2; ++k) \
        acc[ai][bj][m][n] = __builtin_amdgcn_mfma_f32_16x16x32_bf16(Bt[n][k], At[m][k], acc[ai][bj][m][n], 0, 0, 0); __builtin_amdgcn_s_setprio(0); } while (0)
#define PG8_WAIT_V(n) asm volatile("s_waitcnt vmcnt(" #n ")" ::: "memory")
#define PG8_WAIT_L(n) asm volatile("s_waitcnt lgkmcnt(" #n ")" ::: "memory")
#define PG8_BAR __builtin_amdgcn_s_barrier()
#define PG8_SCHED __builtin_amdgcn_sched_barrier(0)
    Unit cur, nxt; int ui = 0;
    if (!S.next(0, cur)) return;
    f32x4 acc[2][2][4][2];
#pragma unroll
    for (int a = 0; a < 2; ++a)
#pragma unroll
        for (int b = 0; b < 2; ++b)
#pragma unroll
            for (int m = 0; m < 4; ++m)
#pragma unroll
                for (int n = 0; n < 2; ++n) acc[a][b][m][n] = (f32x4){0.f, 0.f, 0.f, 0.f};
    bf16x8 At[4][2], B0[2][2], B1[2][2];
    unsigned goff[2][2] = {{0u, 0u}, {0u, 0u}};
    const char* cA = GATHER ? (const char*)g.A : (const char*)g.A + (size_t)cur.pm * tstep; const char* cB = (const char*)g.Bt + (size_t)cur.pn * tstep;
    if constexpr (GATHER) { PG8_GOFF(goff, cur); }
    PG8_STAGE(PG8_SB(0, 0), cB, voffB); PG8_STAGE(PG8_SB(0, 1), cB + hstep, voffB); PG8_STA(PG8_SA(0, 0), cA, 0, goff); PG8_STA(PG8_SA(0, 1), cA, 1, goff);
    if (wr == 1) PG8_BAR;
    PG8_WAIT_V(2); PG8_BAR;
    PG8_STAGE(PG8_SB(1, 0), cB + kstep, voffB); PG8_STA(PG8_SA(1, 0), cA + kstep, 0, goff); PG8_STAGE(PG8_SB(1, 1), cB + hstep + kstep, voffB);
    PG8_WAIT_V(6); PG8_BAR;
    for (;;) {
        const bool has_next = S.next(ui + 1, nxt);
        const char* nA = GATHER ? (const char*)g.A : (has_next ? (const char*)g.A + (size_t)nxt.pm * tstep : cA); const char* nB = has_next ? (const char*)g.Bt + (size_t)nxt.pn * tstep : cB;
#pragma unroll 1
        for (int t = 0; t < nt; t += 2) {
            const bool last = (t == nt - 2);
            const char* a1 = cA + (size_t)(t + 1) * kstep;
            const char* a2 = last ? nA : cA + (size_t)(t + 2) * kstep; const char* b2 = last ? nB : cB + (size_t)(t + 2) * kstep;
            const char* a3 = a2 + kstep; const char* b3 = b2 + kstep;
            PG8_LDB(B0, 0, 0); PG8_LDB(B1, 0, 1); PG8_SCHED; PG8_LDA(At, 0, 0); PG8_STA(PG8_SA(1, 1), a1, 1, goff);
            if constexpr (GATHER) { if (last && has_next) { PG8_GOFF(goff, nxt); } }
            PG8_WAIT_V(8); PG8_WAIT_L(0); PG8_BAR; PG8_MMA(0, 0, At, B0); PG8_MMA(0, 1, At, B1); PG8_BAR; PG8_SCHED;
            PG8_LDA(At, 0, 1); PG8_STAGE(PG8_SB(0, 0), b2, voffB); PG8_STAGE(PG8_SB(0, 1), b2 + hstep, voffB); PG8_STA(PG8_SA(0, 0), a2, 0, goff);
            PG8_WAIT_V(8); PG8_WAIT_L(0); PG8_BAR; PG8_MMA(1, 0, At, B0); PG8_MMA(1, 1, At, B1); PG8_BAR; PG8_SCHED;
            PG8_LDB(B0, 1, 0); PG8_LDB(B1, 1, 1); PG8_SCHED; PG8_LDA(At, 1, 0); PG8_STA(PG8_SA(0, 1), a2, 1, goff);
            PG8_WAIT_V(8); PG8_WAIT_L(0); PG8_BAR; PG8_MMA(0, 0, At, B0); PG8_MMA(0, 1, At, B1); PG8_BAR; PG8_SCHED;
            PG8_LDA(At, 1, 1); PG8_STAGE(PG8_SB(1, 0), b3, voffB); PG8_STAGE(PG8_SB(1, 1), b3 + hstep, voffB); PG8_STA(PG8_SA(1, 0), a3, 0, goff);
            PG8_WAIT_V(8); PG8_WAIT_L(0); PG8_BAR; PG8_MMA(1, 0, At, B0); PG8_MMA(1, 1, At, B1); PG8_BAR; PG8_SCHED;
        }
        if constexpr (ALIGN_EPI) { if (wr == 0) PG8_BAR; }
        E(acc, cur, wr, wc, fr, fq);
        if (!has_next) break;
#pragma unroll
        for (int a = 0; a < 2; ++a)
#pragma unroll
            for (int b = 0; b < 2; ++b)
#pragma unroll
                for (int m = 0; m < 4; ++m)
#pragma unroll
                    for (int n = 0; n < 2; ++n) acc[a][b][m][n] = (f32x4){0.f, 0.f, 0.f, 0.f};
        cur = nxt; cA = nA; cB = nB; ++ui;
        if constexpr (ALIGN_EPI) { if (wr == 1) PG8_BAR; }
    }
    PG8_WAIT_V(0);
    if constexpr (!ALIGN_EPI) { if (wr == 0) PG8_BAR; }
    PG8_BAR;
#undef PG8_SA
#undef PG8_SB
#undef PG8_STAGE
#undef PG8_STA
#undef PG8_GOFF
#undef PG8_LDA
#undef PG8_LDB
#undef PG8_MMA
#undef PG8_WAIT_V
#undef PG8_WAIT_L
#undef PG8_BAR
#undef PG8_SCHED
}
}

#define XB_TMO      128
#define XB_XCNT(j)  (256  + 64 * (j))
#define XB_XSUB(j)  (1280 + 64 * (j))
#define XB_XGEN(j)  (2304 + 64 * (j))
#define XB_TOP      3328
#define XB_TOPGEN   3392
#define XCD_BAR_WORDS 3456
#define XB_SPIN_CAP (1u << 18)
__device__ __forceinline__ unsigned xb_ld(unsigned* p)              { return __hip_atomic_load(p, __ATOMIC_RELAXED, __HIP_MEMORY_SCOPE_AGENT); }
__device__ __forceinline__ unsigned xb_add(unsigned* p, unsigned v) { return __hip_atomic_fetch_add(p, v, __ATOMIC_RELAXED, __HIP_MEMORY_SCOPE_AGENT); }
__device__ __forceinline__ unsigned xb_xcc_id() { return (unsigned)__builtin_amdgcn_s_getreg((3 << 11) | 20) & 0xFu; }
#define XB_SPIN(cond, bar) do { unsigned _sp = 0; while (cond) { __builtin_amdgcn_s_sleep(1); \
    if ((++_sp & 255u) == 0u) { if (xb_ld(&(bar)[XB_TMO])) break; if (_sp > XB_SPIN_CAP) { atomicAdd(&(bar)[XB_TMO], 1u); break; } } } } while (0)
struct XcdBarrier { unsigned* bar; unsigned x; volatile LAS unsigned* st; };
__device__ __forceinline__ XcdBarrier xcd_barrier_post(unsigned* bar, volatile LAS unsigned* st) {
    XcdBarrier b; b.bar = bar; b.x = xb_xcc_id(); b.st = st;
    if (threadIdx.x == 0) (void)xb_add(&bar[XB_XCNT(b.x)], 1u);
    return b;
}
__device__ __forceinline__ void xcd_barrier_complete(unsigned* bar, unsigned x, unsigned& nloc, unsigned& nx) {
    const unsigned G = gridDim.x * gridDim.y * gridDim.z;
    unsigned sum, cnt, mine, sp = 0u;
    for (;;) {
        sum = 0u; cnt = 0u; mine = 0u;
#pragma unroll
        for (unsigned j = 0; j < 16; ++j) { const unsigned c = xb_ld(&bar[XB_XCNT(j)]); sum += c; cnt += (c > 0u) ? 1u : 0u; mine = (j == x) ? c : mine; }
        if (sum == G) break;
        __builtin_amdgcn_s_sleep(1);
        if ((++sp & 255u) == 0u) { if (xb_ld(&bar[XB_TMO])) break; if (sp > XB_SPIN_CAP) { atomicAdd(&bar[XB_TMO], 1u); break; } }
    }
    nloc = mine > 0u ? mine : 1u; nx = cnt > 0u ? cnt : 1u;
}
__device__ __forceinline__ void xcd_barrier(const XcdBarrier& b) {
    asm volatile("s_waitcnt vmcnt(0)" ::: "memory");
    __syncthreads();
    if (threadIdx.x == 0) {
        unsigned* bar = b.bar;
        __builtin_amdgcn_s_waitcnt(0);
        unsigned nloc = b.st[0], nx = b.st[1];
        if (nloc == 0u) { xcd_barrier_complete(bar, b.x, nloc, nx); b.st[0] = nloc; b.st[1] = nx; }
        const unsigned old = xb_add(&bar[XB_XSUB(b.x)], 1u);
        const unsigned gen = old / nloc;
        if (old + 1u == (gen + 1u) * nloc) {
            __builtin_amdgcn_fence(__ATOMIC_RELEASE, "agent");
            asm volatile("s_waitcnt vmcnt(0)" ::: "memory");
            const unsigned og = xb_add(&bar[XB_TOP], 1u);
            const unsigned tg = og / nx;
            if (og + 1u == (tg + 1u) * nx) xb_add(&bar[XB_TOPGEN], 1u);
            else XB_SPIN(xb_ld(&bar[XB_TOPGEN]) == tg, bar);
            __builtin_amdgcn_fence(__ATOMIC_ACQUIRE, "agent");
            xb_add(&bar[XB_XGEN(b.x)], 1u);
            asm volatile("s_waitcnt vmcnt(0)" ::: "memory");
        } else {
            XB_SPIN(xb_ld(&bar[XB_XGEN(b.x)]) == gen, bar);
            __builtin_amdgcn_fence(__ATOMIC_ACQUIRE, "agent");
            asm volatile("s_waitcnt vmcnt(0)" ::: "memory");
        }
    }
    __syncthreads();
}

struct Args { const float* in[25]; float* out; unsigned char* ws; int ph_lo, ph_hi; };
typedef const __attribute__((address_space(4))) Args* ArgsP;
struct Frame {
    LAS unsigned char* lds; volatile LAS unsigned* MISC; gu32* ctl; unsigned char* ws;
    int tid, lane, wave, G, c;
};
__device__ __forceinline__ float wave_sum(float v) {
    v += __builtin_bit_cast(float, __builtin_amdgcn_update_dpp(0, __builtin_bit_cast(int, v), 0xB1, 0xF, 0xF, true));
    v += __builtin_bit_cast(float, __builtin_amdgcn_update_dpp(0, __builtin_bit_cast(int, v), 0x4E, 0xF, 0xF, true));
    v += __builtin_bit_cast(float, __builtin_amdgcn_update_dpp(0, __builtin_bit_cast(int, v), 0x141, 0xF, 0xF, true));
    v += __builtin_bit_cast(float, __builtin_amdgcn_update_dpp(0, __builtin_bit_cast(int, v), 0x140, 0xF, 0xF, true));
    { auto rr = __builtin_amdgcn_permlane16_swap(__float_as_uint(v), __float_as_uint(v), false, false); v = __uint_as_float(rr[0]) + __uint_as_float(rr[1]); }
    { auto rr = __builtin_amdgcn_permlane32_swap(__float_as_uint(v), __float_as_uint(v), false, false); v = __uint_as_float(rr[0]) + __uint_as_float(rr[1]); }
    return v;
}
__device__ __forceinline__ float lx32(float x, bool h5) { auto rr = __builtin_amdgcn_permlane32_swap(__float_as_uint(x), __float_as_uint(x), false, false); return __uint_as_float(h5 ? rr[0] : rr[1]); }
__device__ __forceinline__ float lx16(float x, bool h4) { auto rr = __builtin_amdgcn_permlane16_swap(__float_as_uint(x), __float_as_uint(x), false, false); return __uint_as_float(h4 ? rr[0] : rr[1]); }
__device__ __forceinline__ float lx8(float x) { return __builtin_bit_cast(float, __builtin_amdgcn_update_dpp(0, __builtin_bit_cast(int, x), 0x128, 0xF, 0xF, true)); }
__device__ __forceinline__ float sum8_dpp(float v) {
    v += __builtin_bit_cast(float, __builtin_amdgcn_update_dpp(0, __builtin_bit_cast(int, v), 0xB1, 0xF, 0xF, true));
    v += __builtin_bit_cast(float, __builtin_amdgcn_update_dpp(0, __builtin_bit_cast(int, v), 0x4E, 0xF, 0xF, true));
    v += __builtin_bit_cast(float, __builtin_amdgcn_update_dpp(0, __builtin_bit_cast(int, v), 0x141, 0xF, 0xF, true));
    return v;
}
__device__ __forceinline__ void wave_sum4(float (&p)[4], int lane) {
    const bool h5 = (lane >> 5) & 1, h4 = (lane >> 4) & 1;
    float a0 = h5 ? p[2] : p[0], a1 = h5 ? p[3] : p[1]; const float b0 = h5 ? p[0] : p[2], b1 = h5 ? p[1] : p[3];
    a0 += lx32(b0, h5); a1 += lx32(b1, h5);
    float c = h4 ? a1 : a0; const float d = h4 ? a0 : a1; c += lx16(d, h4);
    c = sum8_dpp(c); c += __builtin_bit_cast(float, __builtin_amdgcn_update_dpp(0, __builtin_bit_cast(int, c), 0x140, 0xF, 0xF, true));
#pragma unroll
    for (int o = 0; o < 4; ++o) p[o] = __builtin_bit_cast(float, __builtin_amdgcn_readlane(__builtin_bit_cast(int, c), 32 * (o >> 1) + 16 * (o & 1)));
}
__device__ __forceinline__ void wave_sum8(float (&p)[8], int lane) {
    const bool h5 = (lane >> 5) & 1, h4 = (lane >> 4) & 1, h3 = (lane >> 3) & 1;
    float a[4];
#pragma unroll
    for (int i = 0; i < 4; ++i) { const float keep = h5 ? p[4 + i] : p[i], send = h5 ? p[i] : p[4 + i]; a[i] = keep + lx32(send, h5); }
    float b[2];
#pragma unroll
    for (int i = 0; i < 2; ++i) { const float keep = h4 ? a[2 + i] : a[i], send = h4 ? a[i] : a[2 + i]; b[i] = keep + lx16(send, h4); }
    float c = h3 ? b[1] : b[0]; const float d = h3 ? b[0] : b[1]; c += lx8(d);
    c = sum8_dpp(c);
#pragma unroll
    for (int o = 0; o < 8; ++o) p[o] = __builtin_bit_cast(float, __builtin_amdgcn_readlane(__builtin_bit_cast(int, c), 32 * (o >> 2) + 16 * ((o >> 1) & 1) + 8 * (o & 1)));
}
__device__ __forceinline__ int mod_sel(int row) { return row < MC ? 2 : ((row - MC) >> 14); }
__device__ __forceinline__ const float* mod_ptr(const unsigned char* ws, int layer, int sel, int part) { return (const float*)(ws + WS_SMALL + SM_MOD) + ((size_t)(layer * 3 + sel) * 6 + part) * DM; }

__device__ __forceinline__ void p0_transpose_item(const float* S, int ldS, int k0, int scol0, bf16* Dst, int ldD, int drow0, int dk0, bool perm, LAS float* scr, int lane) {
    float tv[32];
#pragma unroll
    for (int i = 0; i < 32; ++i) { const int kk = 2 * i + (lane >> 5); tv[i] = S[(size_t)(k0 + kk) * ldS + scol0 + (lane & 31)]; }
#pragma unroll
    for (int i = 0; i < 32; ++i) { const int kk = 2 * i + (lane >> 5); scr[kk * 33 + (lane & 31)] = tv[i]; }
    LDS_WAIT(); asm volatile("" ::: "memory");
    const int c = lane & 7;
#pragma unroll
    for (int j = 0; j < 4; ++j) { const int n = (lane >> 3) + 8 * j;
        int sn = n;
        if (perm) { const int p = (drow0 + n) & 63, i2 = p >> 1, odd = p & 1; const int dim = ((i2 < 16) ? i2 : i2 + 16) + 16 * odd; sn = dim & 31; }
        const LAS float* s = scr + (8 * c) * 33 + sn;
        u32x4 o; o.x = cvt_pk_bf16(s[0 * 33], s[1 * 33]); o.y = cvt_pk_bf16(s[2 * 33], s[3 * 33]); o.z = cvt_pk_bf16(s[4 * 33], s[5 * 33]); o.w = cvt_pk_bf16(s[6 * 33], s[7 * 33]);
        *(GAS u32x4*)(Dst + (size_t)(drow0 + n) * ldD + dk0 + 8 * c) = o; }
    LDS_WAIT(); asm volatile("" ::: "memory");
}
__device__ __forceinline__ void wg_transpose_item(Frame& F, const float* S, int ldS, int k0, int scol0, bf16* Dst, int ldD, int drow_base, int dk0, int mode) {
    LAS float* tile = (LAS float*)F.lds;
    f32x4 tv[8];
#pragma unroll
    for (int r = 0; r < 8; ++r) { const int k = F.wave + 8 * r; tv[r] = *(const f32x4*)(S + (size_t)(k0 + k) * ldS + scol0 + 4 * F.lane); }
#pragma unroll
    for (int r = 0; r < 8; ++r) { const int k = F.wave + 8 * r; *(LAS f32x4*)(tile + k * 256 + ((F.lane ^ ((k >> 3) & 7)) << 2)) = tv[r]; }
    __syncthreads();
    const int c = F.tid & 7, nn = F.tid >> 3;
#pragma unroll
    for (int jj = 0; jj < 4; ++jj) { const int j = nn + 64 * jj;
        int col = j;
        if (mode == 1) { const int p = j & 63, i2 = p >> 1, odd = p & 1; const int dim = ((i2 < 16) ? i2 : i2 + 16) + 16 * odd; col = (j & ~63) + dim; }
        const int drow = drow_base + ((mode == 2) ? ((j >> 7) * 256 + (j & 127)) : j);
        const LAS float* sp = tile + (8 * c) * 256 + (((col >> 2) ^ c) << 2) + (col & 3);
        u32x4 o; o.x = cvt_pk_bf16(sp[0 * 256], sp[1 * 256]); o.y = cvt_pk_bf16(sp[2 * 256], sp[3 * 256]); o.z = cvt_pk_bf16(sp[4 * 256], sp[5 * 256]); o.w = cvt_pk_bf16(sp[6 * 256], sp[7 * 256]);
        *(GAS u32x4*)(Dst + (size_t)drow * ldD + dk0 + 8 * c) = o; }
    __syncthreads();
}
__device__ __forceinline__ float silu_f(float x) { return x / (1.f + __expf(-x)); }
__device__ __forceinline__ void sincos_d(double x, double& s, double& c) {
    const double TWO_PI = 6.283185307179586476925286766559, INV = 0.15915494309189533576888376337251;
    double k = __builtin_rint(x * INV); double r = __builtin_fma(-k, TWO_PI, x);
    const double HALF_PI = 1.5707963267948966192313216916398;
    double q = __builtin_rint(r / HALF_PI); double y = r - q * HALF_PI; int qi = ((int)q) & 3;
    double y2 = y * y;
    double sp = y * (1.0 + y2 * (-1.0 / 6 + y2 * (1.0 / 120 + y2 * (-1.0 / 5040 + y2 * (1.0 / 362880 + y2 * (-1.0 / 39916800 + y2 * (1.0 / 6227020800.0 + y2 * (-1.0 / 1307674368000.0))))))));
    double cp = 1.0 + y2 * (-0.5 + y2 * (1.0 / 24 + y2 * (-1.0 / 720 + y2 * (1.0 / 40320 + y2 * (-1.0 / 3628800 + y2 * (1.0 / 479001600.0 + y2 * (-1.0 / 87178291200.0 + y2 * (1.0 / 20922789888000.0))))))));
    if (qi == 0) { s = sp; c = cp; } else if (qi == 1) { s = cp; c = -sp; } else if (qi == 2) { s = -sp; c = -cp; } else { s = -cp; c = sp; }
}

__device__ __forceinline__ void p0_prologue(Frame& F, ArgsP AP) {
    struct { const float* in[25]; } A;
#pragma unroll
    for (int i = 0; i < 25; ++i) A.in[i] = AP->in[i];
    unsigned char* ws = F.ws;
    {
        LAS float* sv = (LAS float*)(F.lds);
        LAS float* red = (LAS float*)(F.lds + 16384);
        for (int i = F.tid; i < 3 * DM; i += 512) { const int v = i >> 10, k = i & 1023; const float x = (v < 2) ? A.in[1][v * DM + k] : A.in[3][k]; sv[i] = silu_f(x); }
        __syncthreads();
        const int cidx = F.tid & 31, rg = F.tid >> 5;
        for (int it = F.c; it < NLAYER * 192; it += F.G) {
            const int l = it / 192, c0 = (it % 192) * 32;
            const float* W = A.in[4] + (size_t)l * DM * 6144 + c0 + cidx;
            float a0 = 0.f, a1 = 0.f, a2 = 0.f;
#pragma unroll
            for (int ib = 0; ib < 64; ib += 16) { float wv[16];
#pragma unroll
                for (int i = 0; i < 16; ++i) wv[i] = W[(size_t)(rg + 16 * (ib + i)) * 6144];
#pragma unroll
                for (int i = 0; i < 16; ++i) { const int r = rg + 16 * (ib + i); a0 += sv[r] * wv[i]; a1 += sv[1024 + r] * wv[i]; a2 += sv[2048 + r] * wv[i]; } }
            red[(rg * 3 + 0) * 32 + cidx] = a0; red[(rg * 3 + 1) * 32 + cidx] = a1; red[(rg * 3 + 2) * 32 + cidx] = a2;
            __syncthreads();
            if (F.tid < 96) { const int v = F.tid >> 5, cc = F.tid & 31; float s = 0.f;
#pragma unroll
                for (int q = 0; q < 16; ++q) s += red[(q * 3 + v) * 32 + cc];
                ((float*)(ws + WS_SMALL + SM_MOD))[(size_t)(l * 3 + v) * 6144 + c0 + cc] = s + A.in[5][l * 6144 + c0 + cc]; }
            __syncthreads();
        }
    }
    {
        constexpr int W_IN = 16 * 8, W_O = 8 * 4, W_GU = 32 * 2 * 16, W_D = 32 * 4 * 4, W_LAYER = W_IN + W_O + W_GU + W_D;
        for (int it0 = F.c; it0 < NLAYER * W_LAYER; it0 += F.G) {
            const int l = it0 / W_LAYER; int r = it0 % W_LAYER;
            if (r < W_IN) { const int kb = r / 8, nb = r % 8;
                wg_transpose_item(F, A.in[8] + (size_t)l * DM * DIN, DIN, kb * 64, nb * 256, (bf16*)(ws + WS_WIN) + (size_t)l * DIN * DM, DM, nb * 256, kb * 64, (nb >= 2 && nb < 6) ? 1 : 0); continue; } r -= W_IN;
            if (r < W_O) { const int kb = r / 4, nb = r % 4;
                wg_transpose_item(F, A.in[16] + (size_t)l * DM * DM + (size_t)512 * DM, DM, kb * 64, nb * 256, (bf16*)(ws + WS_W2) + (size_t)l * DM * DM, DM, nb * 256, 512 + kb * 64, 0); continue; } r -= W_O;
            if (r < W_GU) { const int e = r / 32, q = r % 32, hb = q / 16, kb = q % 16;
                const float* src = (hb ? A.in[22] : A.in[21]) + ((size_t)l * NEXP + e) * DM * DEXP;
                wg_transpose_item(F, src, DEXP, kb * 64, 0, (bf16*)(ws + WS_WGU) + ((size_t)l * NEXP + e) * 512 * DM, DM, hb * 128, kb * 64, 2); continue; } r -= W_GU;
            { const int e = r / 16, q = r % 16, kb = q / 4, nb = q % 4;
                wg_transpose_item(F, A.in[23] + ((size_t)l * NEXP + e) * DEXP * DM, DM, kb * 64, nb * 256, (bf16*)(ws + WS_WD) + ((size_t)l * NEXP + e) * DM * DEXP, DEXP, nb * 256, kb * 64, 0); }
        }
    }
    const int gw = F.c * 8 + F.wave, NGW = F.G * 8;
    constexpr int I_F = 4 * 16 * 8;
    for (int it0 = gw; it0 < NLAYER * I_F + 64 + 1; it0 += NGW) {
        if (it0 >= NLAYER * I_F) {
            const int x = it0 - NLAYER * I_F;
            if (x < 64) {
                const int idx = x * 64 + F.lane, pos = idx >> 4, f = idx & 15;
                const double inv[16] = {1.0, 0.56234132519034908039, 0.31622776601683793320, 0.17782794100389228012, 0.1, 0.056234132519034908039, 0.031622776601683793320, 0.017782794100389228012,
                                        0.01, 0.0056234132519034908039, 0.0031622776601683793320, 0.0017782794100389228012, 0.001, 0.00056234132519034908039, 0.00031622776601683793320, 0.00017782794100389228012};
                double invf = inv[0];
#pragma unroll
                for (int q = 1; q < 16; ++q) invf = (f == q) ? inv[q] : invf;
                double s, c; sincos_d((double)pos * invf, s, c);
                ((f32x2*)(ws + WS_SMALL + SM_ROPE))[idx] = (f32x2){(float)c, (float)s};
            } else {
                for (int l = 0; l < NLAYER; ++l) {
                    const float d1 = wave_sum(A.in[11][l * 64 + F.lane] * A.in[12][l * 64 + F.lane]);
                    const float d2 = wave_sum(A.in[13][l * 64 + F.lane] * A.in[14][l * 64 + F.lane]);
                    const float lam_init = 0.8f - 0.6f * expf(-0.3f * (float)l);
                    if (F.lane == 0) ((float*)(ws + WS_SMALL + SM_LAM))[l] = expf(d1) - expf(d2) + lam_init;
                }
            }
            continue;
        }
        const int l = it0 / I_F; const int r = it0 % I_F;
        {
            const int g = r / 128, q = r % 128, nb = q / 8, kb = q % 8, n = nb * 64 + F.lane, kk0 = kb * 16;
            const float* pw = A.in[9] + ((size_t)(l * 4 + g) * 128 + kk0) * 128; const float* ps = A.in[10] + l * 512 + g * 128;
            const float* wo = A.in[16] + (size_t)l * DM * DM + (size_t)(g * 128) * DM + n;
            float acc[16];
#pragma unroll
            for (int k = 0; k < 16; ++k) acc[k] = 0.f;
            for (int jb = 0; jb < 128; jb += 16) { float wv[16];
#pragma unroll
                for (int j = 0; j < 16; ++j) wv[j] = wo[(size_t)(jb + j) * DM];
#pragma unroll
                for (int j = 0; j < 16; ++j) { const float w = wv[j] * ps[jb + j];
#pragma unroll
                    for (int k = 0; k < 16; ++k) acc[k] += pw[k * 128 + jb + j] * w; } }
            u32x4 o0, o1; o0.x = cvt_pk_bf16(acc[0], acc[1]); o0.y = cvt_pk_bf16(acc[2], acc[3]); o0.z = cvt_pk_bf16(acc[4], acc[5]); o0.w = cvt_pk_bf16(acc[6], acc[7]);
            o1.x = cvt_pk_bf16(acc[8], acc[9]); o1.y = cvt_pk_bf16(acc[10], acc[11]); o1.z = cvt_pk_bf16(acc[12], acc[13]); o1.w = cvt_pk_bf16(acc[14], acc[15]);
            bf16* d = (bf16*)(ws + WS_W2) + (size_t)l * DM * DM + (size_t)n * DM + g * 128 + kk0;
            *(GAS u32x4*)d = o0; *(GAS u32x4*)(d + 8) = o1;
        }
    }
}

__device__ __forceinline__ const float* src_row0(ArgsP A, int row) { return row < MC ? A->in[2] + (size_t)row * DM : A->in[0] + (size_t)(row - MC) * DM; }
__device__ __forceinline__ void norm_mod_store(const f32x4 (&v)[4], const float* gain, const float* sh, const float* sc, bf16* orow, int lane) {
    f32x4 mg[4], m1[4], m0[4];
#pragma unroll
    for (int j = 0; j < 4; ++j) { const int c = 4 * lane + 256 * j; mg[j] = *(const f32x4*)(gain + c); m1[j] = *(const f32x4*)(sc + c); m0[j] = *(const f32x4*)(sh + c); }
    float ss = 0.f;
#pragma unroll
    for (int j = 0; j < 4; ++j) ss += (v[j].x * v[j].x + v[j].y * v[j].y) + (v[j].z * v[j].z + v[j].w * v[j].w);
    const float rstd = 1.f / sqrtf(wave_sum(ss) * (1.f / DM) + EPS);
#pragma unroll
    for (int j = 0; j < 4; ++j) { const int c = 4 * lane + 256 * j;
        const f32x4 y = (v[j] * rstd) * mg[j] * (m1[j] + 1.f) + m0[j];
        u32x2 o; o.x = cvt_pk_bf16(y.x, y.y); o.y = cvt_pk_bf16(y.z, y.w); *(GAS u32x2*)(orow + c) = o; }
}
__device__ __forceinline__ void phase_norm1_first(Frame& F, ArgsP A) {
    const int gw = F.c * 8 + F.wave, NGW = F.G * 8; bf16* HX = (bf16*)(F.ws + WS_HX);
    for (int m = gw; m < MT; m += NGW) {
        const float* xr = src_row0(A, m); f32x4 v[4];
#pragma unroll
        for (int j = 0; j < 4; ++j) v[j] = *(const f32x4*)(xr + 4 * F.lane + 256 * j);
        const int sel = mod_sel(m);
        norm_mod_store(v, A->in[6], mod_ptr(F.ws, 0, sel, 0), mod_ptr(F.ws, 0, sel, 1), HX + (size_t)m * DM, F.lane);
    }
}
template <bool DRY> __device__ __forceinline__ void phase_combine(Frame& F, ArgsP A, int l) {
    const int gw = F.c * 8 + F.wave, NGW = F.G * 8; bf16* HX = (bf16*)(F.ws + WS_HX); bf16* X = (bf16*)(F.ws + WS_X); const bf16* Y = (const bf16*)(F.ws + WS_U);
    const bool lastl = (l == NLAYER - 1);
    for (int m = gw + (lastl ? MC : 0); m < MT; m += NGW) {
        bf16* xr = X + (size_t)m * DM; f32x4 v[4]; const int sel = mod_sel(m); const float* g2 = mod_ptr(F.ws, l, sel, 5);
#pragma unroll
        for (int j = 0; j < 4; ++j) { const int c = 4 * F.lane + 256 * j; { const u32x2 q = *(const GAS u32x2*)(xr + c); v[j] = (f32x4){bf2f(q.x & 0xffffu), bf2f(q.x >> 16), bf2f(q.y & 0xffffu), bf2f(q.y >> 16)}; }
            const u32x2 y0 = *(const GAS u32x2*)(Y + (size_t)(2 * m) * DM + c), y1 = *(const GAS u32x2*)(Y + (size_t)(2 * m + 1) * DM + c);
            f32x4 ys; ys.x = bf2f(y0.x & 0xffffu) + bf2f(y1.x & 0xffffu); ys.y = bf2f(y0.x >> 16) + bf2f(y1.x >> 16); ys.z = bf2f(y0.y & 0xffffu) + bf2f(y1.y & 0xffffu); ys.w = bf2f(y0.y >> 16) + bf2f(y1.y >> 16);
            v[j] = v[j] + *(const f32x4*)(g2 + c) * ys; }
        if (!lastl) {
            if (!DRY) {
#pragma unroll
            for (int j = 0; j < 4; ++j) { u32x2 o; o.x = cvt_pk_bf16(v[j].x, v[j].y); o.y = cvt_pk_bf16(v[j].z, v[j].w); *(GAS u32x2*)(xr + 4 * F.lane + 256 * j) = o; } }
            norm_mod_store(v, A->in[6] + (l + 1) * DM, mod_ptr(F.ws, l + 1, sel, 0), mod_ptr(F.ws, l + 1, sel, 1), HX + (size_t)m * DM, F.lane);
        } else {
            float ss = 0.f;
#pragma unroll
            for (int j = 0; j < 4; ++j) ss += (v[j].x * v[j].x + v[j].y * v[j].y) + (v[j].z * v[j].z + v[j].w * v[j].w);
            const float rstd = 1.f / sqrtf(wave_sum(ss) * (1.f / DM) + EPS);
            float* orow = A->out + (size_t)(m - MC) * DM; const float* fg = A->in[24];
#pragma unroll
            for (int j = 0; j < 4; ++j) { const int c = 4 * F.lane + 256 * j; *(f32x4*)(orow + c) = (v[j] * rstd) * *(const f32x4*)(fg + c); }
        }
    }
}
template <bool DRY> __device__ __forceinline__ void phase_norm2_route(Frame& F, ArgsP A, int l) {
    const float* rcw = A->in[17]; const float* rcb = A->in[18]; const float* rfw = A->in[19]; const float* rfb = A->in[20]; const float* n2g = A->in[7];
    LAS float* wl = (LAS float*)F.lds;
    for (int k = F.tid; k < DM; k += 512) { const f32x4 w = *(const f32x4*)(rcw + (size_t)l * DM * 4 + k * 4);
        wl[0 * DM + k] = w.x; wl[1 * DM + k] = w.y; wl[2 * DM + k] = w.z; wl[3 * DM + k] = w.w; }
    for (int q = F.tid; q < DM * 8; q += 512) { const int k = q >> 3, o4 = q & 7; const f32x4 w = *(const f32x4*)(rfw + (size_t)l * DM * 32 + k * 32 + 4 * o4);
        wl[(4 + 4 * o4 + 0) * DM + k] = w.x; wl[(4 + 4 * o4 + 1) * DM + k] = w.y; wl[(4 + 4 * o4 + 2) * DM + k] = w.z; wl[(4 + 4 * o4 + 3) * DM + k] = w.w; }
    LAS unsigned* rt_e = (LAS unsigned*)(F.lds + RT_OFF);
    LAS unsigned* rt_p0 = rt_e + 256; LAS unsigned* rt_p1 = rt_p0 + 256; LAS float* rt_w0 = (LAS float*)(rt_p1 + 256); LAS float* rt_w1 = rt_w0 + 256;
    LAS unsigned* cl = (LAS unsigned*)(rt_w1 + 256); LAS unsigned* basev = cl + 32;
    if (F.tid < 32) cl[F.tid] = 0u;
    __syncthreads();
    const int mlo = (l == NLAYER - 1) ? MC : 0, nrows = MT - mlo, per = (nrows + F.G - 1) / F.G;
    const int r0 = mlo + F.c * per, r1 = (r0 + per < MT) ? r0 + per : MT;
    bf16* HX = (bf16*)(F.ws + WS_HX); const bf16* X = (const bf16*)(F.ws + WS_X);
    float bc[4];
#pragma unroll
    for (int o = 0; o < 4; ++o) bc[o] = rcb[l * 4 + o];
    u32x2 xv[4];
    { const int m0 = (r0 + F.wave < r1) ? r0 + F.wave : r0;
#pragma unroll
      for (int j = 0; j < 4; ++j) xv[j] = *(const GAS u32x2*)(X + (size_t)m0 * DM + 4 * F.lane + 256 * j); }
    for (int m = r0 + F.wave; m < r1; m += 8) {
        f32x4 v[4]; float ss = 0.f; u32x2 xn[4];
        { const int mn = (m + 8 < r1) ? m + 8 : m;
#pragma unroll
          for (int j = 0; j < 4; ++j) xn[j] = *(const GAS u32x2*)(X + (size_t)mn * DM + 4 * F.lane + 256 * j); }
#pragma unroll
        for (int j = 0; j < 4; ++j) { v[j] = (f32x4){bf2f(xv[j].x & 0xffffu), bf2f(xv[j].x >> 16), bf2f(xv[j].y & 0xffffu), bf2f(xv[j].y >> 16)};
            ss += (v[j].x * v[j].x + v[j].y * v[j].y) + (v[j].z * v[j].z + v[j].w * v[j].w); }
        const float rstd = 1.f / sqrtf(wave_sum(ss) * (1.f / DM) + EPS);
        const int sel = mod_sel(m); const float* gain = n2g + l * DM; const float* sh = mod_ptr(F.ws, l, sel, 3); const float* sc = mod_ptr(F.ws, l, sel, 4);
        bf16* orow = HX + (size_t)m * DM;
#pragma unroll
        for (int j = 0; j < 4; ++j) { const int c = 4 * F.lane + 256 * j;
            const f32x4 g = *(const f32x4*)(gain + c), s1 = *(const f32x4*)(sc + c), s0 = *(const f32x4*)(sh + c);
            v[j] = (v[j] * rstd) * g * (s1 + 1.f) + s0;
            u32x2 o; o.x = cvt_pk_bf16(v[j].x, v[j].y); o.y = cvt_pk_bf16(v[j].z, v[j].w); *(GAS u32x2*)(orow + c) = o; }
        float lc[4];
#pragma unroll
        for (int o = 0; o < 4; ++o) { f32x2 p2 = {0.f, 0.f};
#pragma unroll
            for (int j = 0; j < 4; ++j) { const f32x4 w = *(const LAS f32x4*)(wl + o * DM + 4 * F.lane + 256 * j);
                p2 = __builtin_elementwise_fma(__builtin_shufflevector(v[j], v[j], 0, 1), __builtin_shufflevector(w, w, 0, 1), p2);
                p2 = __builtin_elementwise_fma(__builtin_shufflevector(v[j], v[j], 2, 3), __builtin_shufflevector(w, w, 2, 3), p2); }
            lc[o] = p2.x + p2.y; }
        wave_sum4(lc, F.lane);
#pragma unroll
        for (int o = 0; o < 4; ++o) lc[o] += bc[o];
        int g = 0; float best = lc[0];
#pragma unroll
        for (int o = 1; o < 4; ++o) if (lc[o] > best) { best = lc[o]; g = o; }
        float den = 0.f;
#pragma unroll
        for (int o = 0; o < 4; ++o) den += __expf(lc[o] - best);
        const float pg = __builtin_amdgcn_rcpf(den);
        float lf[8];
#pragma unroll
        for (int o = 0; o < 8; ++o) { f32x2 p2 = {0.f, 0.f}; const LAS float* wrow = wl + (4 + g * 8 + o) * DM;
#pragma unroll
            for (int j = 0; j < 4; ++j) { const f32x4 w = *(const LAS f32x4*)(wrow + 4 * F.lane + 256 * j);
                p2 = __builtin_elementwise_fma(__builtin_shufflevector(v[j], v[j], 0, 1), __builtin_shufflevector(w, w, 0, 1), p2);
                p2 = __builtin_elementwise_fma(__builtin_shufflevector(v[j], v[j], 2, 3), __builtin_shufflevector(w, w, 2, 3), p2); }
            lf[o] = p2.x + p2.y; }
        wave_sum8(lf, F.lane);
#pragma unroll
        for (int o = 0; o < 8; ++o) lf[o] += rfb[l * 32 + g * 8 + o];
        int i0 = 0; float v0 = lf[0];
#pragma unroll
        for (int o = 1; o < 8; ++o) if (lf[o] > v0) { v0 = lf[o]; i0 = o; }
        int i1 = -1; float v1 = -3.0e38f;
#pragma unroll
        for (int o = 0; o < 8; ++o) if (o != i0 && lf[o] > v1) { v1 = lf[o]; i1 = o; }
        const float ex = __expf(v1 - v0); const float rq = pg * __builtin_amdgcn_rcpf(1.f + ex); const float w0 = rq, w1 = rq * ex;
        if (F.lane == 0) { const int e0 = g * 8 + i0, e1 = g * 8 + i1, lr = m - r0;
            rt_e[lr] = (unsigned)e0 | ((unsigned)e1 << 8); rt_w0[lr] = w0; rt_w1[lr] = w1;
            rt_p0[lr] = __hip_atomic_fetch_add(cl + e0, 1u, __ATOMIC_RELAXED, __HIP_MEMORY_SCOPE_WORKGROUP);
            rt_p1[lr] = __hip_atomic_fetch_add(cl + e1, 1u, __ATOMIC_RELAXED, __HIP_MEMORY_SCOPE_WORKGROUP); }
#pragma unroll
        for (int j = 0; j < 4; ++j) xv[j] = xn[j];
    }
    __syncthreads();
    if (DRY) { __syncthreads(); return; }
    if (F.tid < 32) basev[F.tid] = __hip_atomic_fetch_add((unsigned*)(F.ctl + CW_CNT + (l * 32 + F.tid) * 64), cl[F.tid], RLX_AGENT);
    __syncthreads();
    unsigned* LIST = (unsigned*)(F.ws + WS_LIST); float* GWT = (float*)(F.ws + WS_GW);
    for (int lr = F.tid; lr < r1 - r0; lr += 512) { const unsigned ee = rt_e[lr]; const int e0 = ee & 255, e1 = (ee >> 8) & 255, m = r0 + lr;
        const unsigned p0 = basev[e0] + rt_p0[lr], p1 = basev[e1] + rt_p1[lr];
        LIST[(size_t)e0 * CAP + p0] = 2u * m; GWT[(size_t)e0 * CAP + p0] = rt_w0[lr];
        LIST[(size_t)e1 * CAP + p1] = 2u * m + 1u; GWT[(size_t)e1 * CAP + p1] = rt_w1[lr]; }
    __syncthreads();
}

struct EpiQKV {
    bf16* U; const f32x2* rope; unsigned* kmax;
    __device__ __forceinline__ void operator()(const f32x4 (&acc)[2][2][4][2], const pg8::Unit& u, int wr, int wc, int fr, int fq) const {
        const int typ = u.pn >> 1;
        bf16* base = U + (size_t)typ * (SZ_QKV / 2);
        const int cb = (u.pn & 1) * 256 + wc * 32 + 8 * fq;
        float kh[2] = {0.f, 0.f};
#pragma unroll
        for (int ai = 0; ai < 2; ++ai)
#pragma unroll
            for (int m = 0; m < 4; ++m) {
                const int row = u.pm * 256 + ai * 128 + wr * 64 + m * 16 + fr;
                const bool lat = row >= MC; const int t = (row - MC) & (SEQ - 1);
#pragma unroll
                for (int bj = 0; bj < 2; ++bj) {
                    const int c = cb + bj * 128;
                    f32x4 v0 = acc[ai][bj][m][0], v1 = acc[ai][bj][m][1];
                    if (typ == 1 || typ == 2) {
                        if (lat) {
                            const int i0 = (c & 63) >> 1, axis = i0 >> 4, f0 = i0 & 15, pos = axis ? (t & (GRIDW - 1)) : (t >> 6);
                            const f32x4 cs0 = *(const f32x4*)(rope + pos * 16 + f0), cs1 = *(const f32x4*)(rope + pos * 16 + f0 + 2);
                            f32x4 r0, r1;
                            r0.x = v0.x * cs0.x - v0.y * cs0.y; r0.y = v0.y * cs0.x + v0.x * cs0.y; r0.z = v0.z * cs0.z - v0.w * cs0.w; r0.w = v0.w * cs0.z + v0.z * cs0.w;
                            r1.x = v1.x * cs1.x - v1.y * cs1.y; r1.y = v1.y * cs1.x + v1.x * cs1.y; r1.z = v1.z * cs1.z - v1.w * cs1.w; r1.w = v1.w * cs1.z + v1.z * cs1.w;
                            v0 = r0; v1 = r1;
                        }
                        if (typ == 1) { v0 = v0 * QSCALE; v1 = v1 * QSCALE; }
                    }
                    u32x4 w; w.x = cvt_pk_bf16(v0.x, v0.y); w.y = cvt_pk_bf16(v0.z, v0.w); w.z = cvt_pk_bf16(v1.x, v1.y); w.w = cvt_pk_bf16(v1.z, v1.w);
                    *(GAS u32x4*)(base + (size_t)row * 512 + c) = w;
                    if (typ == 2) { float hs = (v0.x * v0.x + v0.y * v0.y) + (v0.z * v0.z + v0.w * v0.w) + (v1.x * v1.x + v1.y * v1.y) + (v1.z * v1.z + v1.w * v1.w);
                        hs += __shfl_xor(hs, 16); hs += __shfl_xor(hs, 32); kh[bj] = fmaxf(kh[bj], hs); }
                }
            }
        if (typ == 2) {
            const int b = (u.pm == 0) ? 0 : (u.pm == 1) ? 1 : ((u.pm - 2) >> 6);
#pragma unroll
            for (int bj = 0; bj < 2; ++bj) { float x = kh[bj];
#pragma unroll
                for (int o = 1; o < 16; o <<= 1) x = fmaxf(x, __shfl_xor(x, o));
                if (fr == 0 && fq == 0) atomicMax(kmax + ((b * 4 + (u.pn & 1) * 2 + bj) * 2 + (wc >> 1)) * 64, __float_as_uint(x)); }
        }
    }
};
struct EpiRes {
    const float* ctx0; const float* x0; const unsigned char* ws; bf16* X; int layer, row_off; bool dry;
    __device__ __forceinline__ void operator()(const f32x4 (&acc)[2][2][4][2], const pg8::Unit& u, int wr, int wc, int fr, int fq) const {
        const int rowt = row_off + u.pm * 256; const int sel = mod_sel(rowt); const float* g1 = mod_ptr(ws, layer, sel, 2);
        const int c0 = u.pn * 256 + wc * 32 + 8 * fq;
        f32x4 gv[2][2];
#pragma unroll
        for (int bj = 0; bj < 2; ++bj)
#pragma unroll
            for (int n = 0; n < 2; ++n) gv[bj][n] = *(const f32x4*)(g1 + c0 + bj * 128 + 4 * n);
#pragma unroll
        for (int ai = 0; ai < 2; ++ai)
#pragma unroll
            for (int m = 0; m < 4; ++m) {
                const int row = rowt + ai * 128 + wr * 64 + m * 16 + fr;
#pragma unroll
                for (int bj = 0; bj < 2; ++bj) { const int c = c0 + bj * 128; f32x4 r0, r1;
                    if (layer == 0) { const float* res = (row < MC ? ctx0 + (size_t)row * DM : x0 + (size_t)(row - MC) * DM) + c; r0 = *(const f32x4*)res; r1 = *(const f32x4*)(res + 4); }
                    else { const u32x4 q = *(const GAS u32x4*)(X + (size_t)row * DM + c);
                        r0 = (f32x4){bf2f(q.x & 0xffffu), bf2f(q.x >> 16), bf2f(q.y & 0xffffu), bf2f(q.y >> 16)}; r1 = (f32x4){bf2f(q.z & 0xffffu), bf2f(q.z >> 16), bf2f(q.w & 0xffffu), bf2f(q.w >> 16)}; }
                    const f32x4 v0 = r0 + gv[bj][0] * acc[ai][bj][m][0], v1 = r1 + gv[bj][1] * acc[ai][bj][m][1];
                    u32x4 w; w.x = cvt_pk_bf16(v0.x, v0.y); w.y = cvt_pk_bf16(v0.z, v0.w); w.z = cvt_pk_bf16(v1.x, v1.y); w.w = cvt_pk_bf16(v1.z, v1.w);
                    if (!dry) *(GAS u32x4*)(X + (size_t)row * DM + c) = w; }
            }
    }
};
struct EpiGateUp {
    bf16* HID; const volatile LAS float* ulgw;
    __device__ __forceinline__ void operator()(const f32x4 (&acc)[2][2][4][2], const pg8::Unit& u, int wr, int wc, int fr, int fq) const {
        const int pn = u.pn & 1, c0 = pn * 128 + wc * 32 + 8 * fq;
#pragma unroll
        for (int ai = 0; ai < 2; ++ai)
#pragma unroll
            for (int m = 0; m < 4; ++m) {
                const int lr = ai * 128 + wr * 64 + m * 16 + fr; const float gw = ulgw[u.ui * 256 + lr];
                float h[8];
#pragma unroll
                for (int n = 0; n < 2; ++n)
#pragma unroll
                    for (int j = 0; j < 4; ++j) { const float a = acc[ai][0][m][n][j], b = acc[ai][1][m][n][j];
                        const float s = a * __builtin_amdgcn_rcpf(1.f + __builtin_amdgcn_exp2f(-1.4426950408889634f * a)); h[n * 4 + j] = s * b * gw; }
                u32x4 w; w.x = cvt_pk_bf16(h[0], h[1]); w.y = cvt_pk_bf16(h[2], h[3]); w.z = cvt_pk_bf16(h[4], h[5]); w.w = cvt_pk_bf16(h[6], h[7]);
                *(GAS u32x4*)(HID + ((size_t)u.pm * 256 + lr) * DEXP + c0) = w;
            }
    }
};
struct EpiDown {
    bf16* Y; bf16* dummy; const volatile LAS unsigned* ultok;
    __device__ __forceinline__ void operator()(const f32x4 (&acc)[2][2][4][2], const pg8::Unit& u, int wr, int wc, int fr, int fq) const {
        const int pn = u.pn & 3, c0 = pn * 256 + wc * 32 + 8 * fq;
#pragma unroll
        for (int ai = 0; ai < 2; ++ai)
#pragma unroll
            for (int m = 0; m < 4; ++m) {
                const int lr = ai * 128 + wr * 64 + m * 16 + fr; const unsigned tk = ultok[u.ui * 256 + lr];
                bf16* dst = (tk == 0xFFFFFFFFu ? dummy : Y + (size_t)tk * DM) + c0;
#pragma unroll
                for (int bj = 0; bj < 2; ++bj) { const f32x4 v0 = acc[ai][bj][m][0], v1 = acc[ai][bj][m][1];
                    u32x4 w; w.x = cvt_pk_bf16(v0.x, v0.y); w.y = cvt_pk_bf16(v0.z, v0.w); w.z = cvt_pk_bf16(v1.x, v1.y); w.w = cvt_pk_bf16(v1.z, v1.w);
                    *(GAS u32x4*)(dst + bj * 128) = w; }
            }
    }
};
__device__ __forceinline__ void moe_setup(Frame& F, int l, int ntn) {
    volatile LAS unsigned* P = F.MISC + 16; volatile LAS unsigned* C = F.MISC + 64; volatile LAS int* T = (volatile LAS int*)(F.MISC + 128);
    if (F.tid < 32) C[F.tid] = __hip_atomic_load((unsigned*)(F.ctl + CW_CNT + (l * 32 + F.tid) * 64), RLX_AGENT);
    __syncthreads();
    if (F.tid == 0) { unsigned s = 0; for (int e = 0; e < 32; ++e) { P[e] = s; s += (C[e] + 255u) >> 8; } P[32] = s;
        int n = 0;
        for (int i = 0; i < 6; ++i) { const int L = i * F.G + F.c; if (L >= (int)s * ntn) break; const int gb = L / ntn, pn = L % ntn; int e = 0;
            for (int k = 1; k < 32; ++k) e = ((int)P[k] <= gb) ? k : e;
            T[2 + 2 * i] = gb; T[3 + 2 * i] = e * ntn + pn; T[16 + 2 * i] = e; T[17 + 2 * i] = gb - (int)P[e]; n = i + 1; }
        T[0] = n; }
    __syncthreads();
    volatile LAS unsigned* ultok = (volatile LAS unsigned*)(F.lds + UL_OFF); volatile LAS float* ulgw = (volatile LAS float*)(F.lds + UL_OFF + 6144);
    const unsigned* LIST = (const unsigned*)(F.ws + WS_LIST); const float* GWT = (const float*)(F.ws + WS_GW);
    const int nu = T[0];
    for (int i = 0; i < nu; ++i) { const int e = T[16 + 2 * i], lb = T[17 + 2 * i], cnt = (int)C[e];
        if (F.tid < 256) { const int pos = lb * 256 + F.tid; const bool ok = pos < cnt;
            ultok[i * 256 + F.tid] = ok ? LIST[(size_t)e * CAP + pos] : 0xFFFFFFFFu; ulgw[i * 256 + F.tid] = ok ? GWT[(size_t)e * CAP + pos] : 0.f; } }
    __syncthreads();
}

__device__ __forceinline__ void phase_pool(Frame& F) {
    const bf16* U = (const bf16*)(F.ws + WS_U); bf16* AO = (bf16*)(F.ws + WS_HX);
    const int cg = F.tid & 63, rs = F.tid >> 6, g = cg >> 4, w = 2 << g, left = w >> 1, right = w - 1 - left;
    LAS unsigned char* tile = F.lds;
#define ACC8(S, X, OP) do { S[0] OP bf2f(X.x & 0xffffu); S[1] OP bf2f(X.x >> 16); S[2] OP bf2f(X.y & 0xffffu); S[3] OP bf2f(X.y >> 16); S[4] OP bf2f(X.z & 0xffffu); S[5] OP bf2f(X.z >> 16); S[6] OP bf2f(X.w & 0xffffu); S[7] OP bf2f(X.w >> 16); } while (0)
    for (int blk = F.c; blk < MT / 64; blk += F.G) {
        const int rowb = blk * 64;
        const int seq0 = rowb < MC ? (rowb & ~(NCTX - 1)) : MC + ((rowb - MC) & ~(SEQ - 1)); const int n = rowb < MC ? NCTX : SEQ;
        const int tb = rowb - seq0; int lo = tb - 8; lo = lo < 0 ? 0 : lo; int hi = tb + 64 + 7; hi = hi > n ? n : hi;
        const int nchunk = (hi - lo) * 64;
        const bf16* Us = U + (size_t)(seq0 + lo) * 512;
        __syncthreads();
        u32x4 st[10];
#pragma unroll
        for (int i = 0; i < 10; ++i) { const int c = F.tid + i * 512; if (c < nchunk) st[i] = *(const GAS u32x4*)(Us + (size_t)c * 8); }
#pragma unroll
        for (int i = 0; i < 10; ++i) { const int c = F.tid + i * 512; if (c < nchunk) *(LAS u32x4*)(tile + c * 16) = st[i]; }
        __syncthreads();
        const LAS unsigned char* col = tile + cg * 16 - lo * 1024;
        const int t0 = tb + rs * 8;
        float s[8];
#pragma unroll
        for (int k = 0; k < 8; ++k) s[k] = 0.f;
        int l0 = t0 - left; l0 = l0 < 0 ? 0 : l0; int h0 = t0 + right + 1; h0 = h0 > n ? n : h0;
        for (int i = l0; i < h0; ++i) { const u32x4 x = *(const LAS u32x4*)(col + i * 1024); ACC8(s, x, +=); }
#pragma unroll
        for (int k = 0; k < 8; ++k) {
            const int t = t0 + k;
            if (k > 0) {
                const int add = t + right, sub = t - 1 - left;
                if (add < n) { const u32x4 x = *(const LAS u32x4*)(col + add * 1024); ACC8(s, x, +=); }
                if (sub >= 0) { const u32x4 x = *(const LAS u32x4*)(col + sub * 1024); ACC8(s, x, -=); }
            }
            int l2 = t - left; l2 = l2 < 0 ? 0 : l2; int h2 = t + right + 1; h2 = h2 > n ? n : h2; const float ic = 1.f / (float)(h2 - l2);
            const u32x4 x = *(const LAS u32x4*)(col + t * 1024);
            u32x4 o; o.x = cvt_pk_bf16(s[0] * ic - bf2f(x.x & 0xffffu), s[1] * ic - bf2f(x.x >> 16)); o.y = cvt_pk_bf16(s[2] * ic - bf2f(x.y & 0xffffu), s[3] * ic - bf2f(x.y >> 16));
            o.z = cvt_pk_bf16(s[4] * ic - bf2f(x.z & 0xffffu), s[5] * ic - bf2f(x.z >> 16)); o.w = cvt_pk_bf16(s[6] * ic - bf2f(x.w & 0xffffu), s[7] * ic - bf2f(x.w >> 16));
            *(GAS u32x4*)(AO + (size_t)(seq0 + t) * DM + cg * 8) = o;
        }
    }
#undef ACC8
    __syncthreads();
}

namespace dattn {
constexpr int KVBLK = 64;
#define SBAR() __builtin_amdgcn_sched_barrier(0)
__device__ __forceinline__ int crow(int r, int hi) { return (r & 3) + 8 * (r >> 2) + 4 * hi; }
typedef __bf16 bf16x2_t __attribute__((ext_vector_type(2))); typedef short v4i16_t __attribute__((ext_vector_type(4)));
__device__ __forceinline__ unsigned cvtpk(float lo, float hi) { f32x2 v = {lo, hi}; bf16x2_t b = __builtin_convertvector(v, bf16x2_t); return __builtin_bit_cast(unsigned, b); }
constexpr int RING = 3, SLOTB = 16384, K_RING = 0, V_RING = RING * SLOTB, LDS_WSCR3 = 2 * RING * SLOTB;
#define WAITBAR(N) asm volatile("s_waitcnt vmcnt(" #N ")\n\ts_barrier" ::: "memory")
typedef LAS const char* lds_cptr;
__device__ __forceinline__ s16x4 vtr(lds_cptr p) { return __builtin_bit_cast(s16x4, __builtin_amdgcn_ds_read_tr16_b64_v4i16((LAS v4i16_t*)p)); }
__device__ __forceinline__ void attn_unit_v4(const bf16* __restrict__ Qg, const bf16* __restrict__ Kg, const bf16* __restrict__ Vg, int seg0, int nt0, int seg1, int NT,
                                             bf16* AOg, float lam, const float* subg, float post, float kmax_s0, float kmax_s1, LAS unsigned char* ldsl, char* lds) {
  const int tid = threadIdx.x, wid = __builtin_amdgcn_readfirstlane(tid >> 6), lane = tid & 63, r32 = lane & 31, hi = lane >> 5, sub = wid >> 2, qb = wid & 3;
  float* wsf = (float*)(lds + LDS_WSCR3) + wid * 64; float* li_l = wsf;
  float l_reg = 0; f32x16 o[4] = {}; bf16x8 qr[4];
  const bf16* Qw = Qg + (size_t)(qb * 32 + r32) * 512 + sub * 64 + hi * 8;
#pragma unroll
  for (int d0 = 0; d0 < 4; ++d0) qr[d0] = *reinterpret_cast<const bf16x8*>(Qw + d0 * 16);
  f32x16 cin;
  { float qs = 0.f;
#pragma unroll
    for (int d0 = 0; d0 < 4; ++d0)
#pragma unroll
      for (int e = 0; e < 8; ++e) { const float x = bf2f((unsigned)(unsigned short)qr[d0][e]); qs += x * x; }
    { auto rr = __builtin_amdgcn_permlane32_swap(__float_as_uint(qs), __float_as_uint(qs), false, false); qs = __uint_as_float(rr[0]) + __uint_as_float(rr[1]); }
    const float c = -fmaxf(0.f, 1.01f * sqrtf(qs * 2.f * (sub ? kmax_s1 : kmax_s0)) - 60.f);
#pragma unroll
    for (int r = 0; r < 16; ++r) cin[r] = c; }
  const unsigned koff = (unsigned)(lane * 512 + wid * 8);
  const int vst = 2 * wid + (lane >> 5), vy = lane & 31, vk = (vst >> 2) * 8 + (vy >> 2);
  const unsigned voff = (unsigned)(vk * 512 + (vst & 3) * 32 + (vy & 3) * 8);
  const unsigned pieceoff = (unsigned)wid * 1024u;
  const lds_cptr kp0 = (lds_cptr)ldsl + K_RING + (sub * 8 + hi) * 1024 + r32 * 16;
  const lds_cptr vp0 = (lds_cptr)ldsl + V_RING + ((lane >> 4) & 1) * 32 + (lane & 3) * 8 + (4 * hi + ((lane & 15) >> 2)) * 64;
#define TROW(j) ((j) < nt0 ? seg0 + (j) * 64 : seg1 + ((j) - nt0) * 64)
#define DMA16(gp, loff) __builtin_amdgcn_global_load_lds((const unsigned*)(gp), (LAS unsigned*)(ldsl + (loff)), 16, 0, 0)
#define ISSUE_K(t, slot) do { const int _t = (t) < NT ? (t) : NT - 1; const bf16* _p = Kg + (size_t)TROW(_t) * 512 + koff; const unsigned _l = K_RING + (slot) * SLOTB + pieceoff; DMA16(_p, _l); DMA16(_p + 64, _l + 8192u); } while (0)
#define ISSUE_V(t, slot) do { const int _t = (t) < NT ? (t) : NT - 1; const bf16* _p = Vg + (size_t)TROW(_t) * 512 + voff; const unsigned _l = V_RING + (slot) * SLOTB + pieceoff; DMA16(_p, _l); DMA16(_p + 32 * 512, _l + 8192u); } while (0)
#define NEXT3(m) ((m) == 2 ? 0 : (m) + 1)
#define PIN(x) asm volatile("" : "+v"(x))
#define EX(v) __builtin_amdgcn_exp2f(v)
#define PKW(P, B) cvtpk(P[B], P[(B) + 1])
#define PAF(k) __builtin_bit_cast(bf16x8, pw##k)
#define KRD(f) (*(const LAS bf16x8*)(kp_ + ((f) >> 1) * 2048 + ((f) & 1) * 512))
#define KLDA(f) asm volatile("ds_read_b128 %0, %1 offset:%2" : "=v"(ka) : "v"(kad_), "i"(((f) >> 1) * 2048 + ((f) & 1) * 512))
#define KLDB(f) asm volatile("ds_read_b128 %0, %1 offset:%2" : "=v"(kb) : "v"(kad_), "i"(((f) >> 1) * 2048 + ((f) & 1) * 512))
#define KLDC(f) asm volatile("ds_read_b128 %0, %1 offset:%2" : "=v"(kc) : "v"(kad_), "i"(((f) >> 1) * 2048 + ((f) & 1) * 512))
#define VLDA(i) do { asm volatile("ds_read_b64_tr_b16 %0, %1 offset:%2" : "=v"(vlo[(i) % 3]) : "v"(vad_), "i"(((i) & 3) * 512 + ((i) >> 2) * 4096)); \
                     asm volatile("ds_read_b64_tr_b16 %0, %1 offset:%2" : "=v"(vhi[(i) % 3]) : "v"(vad_), "i"(((i) & 3) * 512 + ((i) >> 2) * 4096 + 2048)); } while (0)
#define LWAITM(N) asm volatile("s_waitcnt lgkmcnt(" #N ")" ::: "memory")
#define VRD(i) do { vlo[(i) % 3] = vtr(vp_ + ((i) & 3) * 512 + ((i) >> 2) * 4096); vhi[(i) % 3] = vtr(vp_ + ((i) & 3) * 512 + ((i) >> 2) * 4096 + 2048); } while (0)
#define VFR(i) (bf16x8){vlo[(i) % 3][0], vlo[(i) % 3][1], vlo[(i) % 3][2], vlo[(i) % 3][3], vhi[(i) % 3][0], vhi[(i) % 3][1], vhi[(i) % 3][2], vhi[(i) % 3][3]}
#define MF(a, b, c) __builtin_amdgcn_mfma_f32_32x32x16_bf16(a, b, c, 0, 0, 0)
#define GAPA(NW, MFX, NEXTK, A0, A1, A2, A3, W0, W1, PW) do { LWAITM(NW); SBAR(); MFX; SBAR(); NEXTK; sacc += A0; sacc2 += A1; sacc += A2; sacc2 += A3; PIN(sacc); PIN(sacc2); W0; W1; PIN(PW); SBAR(); } while (0)
#define GAPB(NW, i, X, B, XTRA) do { LWAITM(NW); SBAR(); o[(i) & 3] = MF(PAF_SEL((i) >> 2), VFR(i), o[(i) & 3]); SBAR(); if ((i) + 2 < 16) VLDA((i) + 2); XTRA; X[B] = EX(X[B]); X[(B) + 1] = EX(X[(B) + 1]); PIN(X); SBAR(); } while (0)
#define PAF_SEL(k) ((k) == 0 ? PAF(0) : (k) == 1 ? PAF(1) : (k) == 2 ? PAF(2) : PAF(3))
#define STEP(C0, C1, P0, P1, ks_, vs_, tk_, sk_, tv_, sv_) do { SBAR(); \
    const unsigned kad_ = kbase + (unsigned)(ks_) * SLOTB, vad_ = vbase + (unsigned)(vs_) * SLOTB; \
    const bf16* kgp_ = Kg + (size_t)TROW(((tk_) < NT ? (tk_) : NT - 1)) * 512 + koff; const bf16* vgp_ = Vg + (size_t)TROW(((tv_) < NT ? (tv_) : NT - 1)) * 512 + voff; \
    const unsigned kl_ = K_RING + (sk_) * SLOTB + pieceoff, vl_ = V_RING + (sv_) * SLOTB + pieceoff; \
    bf16x8 ka, kb, kc; KLDA(0); KLDB(1); KLDC(2); float sacc = P0[0], sacc2 = P0[1]; SBAR(); \
    LWAITM(2); SBAR(); C0 = MF(ka, qr[0], cin); SBAR(); KLDA(3); SBAR(); \
    LWAITM(2); SBAR(); C1 = MF(kb, qr[0], cin); SBAR(); KLDB(4); SBAR(); \
    LWAITM(2); SBAR(); C0 = MF(kc, qr[1], C0); SBAR(); KLDC(5); sacc += P0[2]; sacc2 += P0[3]; sacc += P0[4]; sacc2 += P0[5]; sacc += P0[6]; PIN(sacc); PIN(sacc2); pw0[0] = PKW(P0, 0); pw0[1] = PKW(P0, 2); pw0[2] = PKW(P0, 4); PIN(pw0); SBAR(); \
    LWAITM(2); SBAR(); C1 = MF(ka, qr[1], C1); SBAR(); KLDA(6); sacc2 += P0[7]; sacc += P0[8]; sacc2 += P0[9]; sacc += P0[10]; sacc2 += P0[11]; PIN(sacc); PIN(sacc2); pw0[3] = PKW(P0, 6); pw1[0] = PKW(P0, 8); pw1[1] = PKW(P0, 10); PIN(pw0); PIN(pw1); SBAR(); \
    LWAITM(2); SBAR(); C0 = MF(kb, qr[2], C0); SBAR(); KLDB(7); sacc += P0[12]; sacc2 += P0[13]; sacc += P0[14]; sacc2 += P0[15]; sacc += P1[0]; PIN(sacc); PIN(sacc2); pw1[2] = PKW(P0, 12); pw1[3] = PKW(P0, 14); pw2[0] = PKW(P1, 0); PIN(pw1); PIN(pw2); SBAR(); \
    LWAITM(2); SBAR(); C1 = MF(kc, qr[2], C1); SBAR(); ; sacc2 += P1[1]; sacc += P1[2]; sacc2 += P1[3]; sacc += P1[4]; sacc2 += P1[5]; PIN(sacc); PIN(sacc2); pw2[1] = PKW(P1, 2); pw2[2] = PKW(P1, 4); pw2[3] = PKW(P1, 6); PIN(pw2); SBAR(); \
    LWAITM(1); SBAR(); C0 = MF(ka, qr[3], C0); SBAR(); VLDA(0); sacc += P1[6]; sacc2 += P1[7]; sacc += P1[8]; sacc2 += P1[9]; sacc += P1[10]; PIN(sacc); PIN(sacc2); pw3[0] = PKW(P1, 8); pw3[1] = PKW(P1, 10); PIN(pw3); SBAR(); \
    LWAITM(2); SBAR(); C1 = MF(kb, qr[3], C1); SBAR(); VLDA(1); sacc2 += P1[11]; sacc += P1[12]; sacc2 += P1[13]; sacc += P1[14]; sacc2 += P1[15]; PIN(sacc); PIN(sacc2); pw3[2] = PKW(P1, 12); pw3[3] = PKW(P1, 14); PIN(pw3); SBAR(); \
    l_reg += sacc + sacc2; \
    GAPB(2, 0, C0, 0, );  GAPB(2, 1, C0, 2, );  GAPB(2, 2, C0, 4, DMA16(kgp_, kl_));   GAPB(2, 3, C0, 6, );   GAPB(2, 4, C0, 8, );   GAPB(2, 5, C0, 10, );  GAPB(2, 6, C0, 12, DMA16(kgp_ + 64, kl_ + 8192u));  GAPB(2, 7, C0, 14, ); \
    GAPB(2, 8, C1, 0, );  GAPB(2, 9, C1, 2, );  GAPB(2, 10, C1, 4, DMA16(vgp_, vl_));  GAPB(2, 11, C1, 6, );  GAPB(2, 12, C1, 8, );  GAPB(2, 13, C1, 10, ); GAPB(2, 14, C1, 12, DMA16(vgp_ + 32 * 512, vl_ + 8192u)); GAPB(0, 15, C1, 14, ); \
  } while (0)
  f32x16 pA0, pA1, pB0, pB1; u32x4 pw0, pw1, pw2, pw3; s16x4 vlo[3], vhi[3];
  const unsigned kbase = (unsigned)(__UINTPTR_TYPE__)kp0, vbase = (unsigned)(__UINTPTR_TYPE__)vp0;
  if (wid >= 4) __builtin_amdgcn_s_setprio(1);
  ISSUE_K(0, 0); ISSUE_K(1, 1); ISSUE_V(0, 0);
  WAITBAR(4);
  ISSUE_K(2, 2); ISSUE_V(1, 1);
  { const lds_cptr kp_ = kp0;
    pA0 = MF(KRD(0), qr[0], cin); pA1 = MF(KRD(1), qr[0], cin); pA0 = MF(KRD(2), qr[1], pA0); pA1 = MF(KRD(3), qr[1], pA1);
    pA0 = MF(KRD(4), qr[2], pA0); pA1 = MF(KRD(5), qr[2], pA1); pA0 = MF(KRD(6), qr[3], pA0); pA1 = MF(KRD(7), qr[3], pA1);
#pragma unroll
    for (int r = 0; r < 16; ++r) { pA0[r] = EX(pA0[r]); pA1[r] = EX(pA1[r]); } }
  int m = 1;
  for (int t = 1; t + 1 < NT; t += 2) {
    const int m1 = NEXT3(m), m2 = NEXT3(m1);
    WAITBAR(4);
    STEP(pB0, pB1, pA0, pA1, m, m2, t + 2, m2, t + 1, m1);
    WAITBAR(4);
    STEP(pA0, pA1, pB0, pB1, m1, m, t + 3, m, t + 2, m2);
    m = m2;
  }
  { const int m2 = (m == 0) ? 2 : m - 1;
    WAITBAR(4);
    STEP(pB0, pB1, pA0, pA1, m, m2, NT, m2, NT, NEXT3(m));
    WAITBAR(0);
    { float sacc = 0.f;
#pragma unroll
      for (int r = 0; r < 16; ++r) sacc += pB0[r] + pB1[r];
      l_reg += sacc; }
    pw0 = (u32x4){PKW(pB0, 0), PKW(pB0, 2), PKW(pB0, 4), PKW(pB0, 6)}; pw1 = (u32x4){PKW(pB0, 8), PKW(pB0, 10), PKW(pB0, 12), PKW(pB0, 14)};
    pw2 = (u32x4){PKW(pB1, 0), PKW(pB1, 2), PKW(pB1, 4), PKW(pB1, 6)}; pw3 = (u32x4){PKW(pB1, 8), PKW(pB1, 10), PKW(pB1, 12), PKW(pB1, 14)};
    const lds_cptr vp_ = vp0 + m * SLOTB;
#pragma unroll
    for (int i = 0; i < 16; ++i) { const s16x4 a = vtr(vp_ + (i & 3) * 512 + (i >> 2) * 4096), b = vtr(vp_ + (i & 3) * 512 + (i >> 2) * 4096 + 2048);
      o[i & 3] = MF(PAF_SEL(i >> 2), ((bf16x8){a[0], a[1], a[2], a[3], b[0], b[1], b[2], b[3]}), o[i & 3]); } }
  __builtin_amdgcn_s_setprio(0);
  asm volatile("s_waitcnt vmcnt(0) lgkmcnt(0)" ::: "memory");
  __syncthreads();
  float* E = (float*)lds;
  { auto rr = __builtin_amdgcn_permlane32_swap(__float_as_uint(l_reg), __float_as_uint(l_reg), false, false); l_reg = __uint_as_float(rr[0]) + __uint_as_float(rr[1]); }
  if (hi == 0) li_l[r32] = l_reg; asm volatile("s_waitcnt lgkmcnt(0)" ::: "memory");
  float rli[16];
#pragma unroll
  for (int r = 0; r < 16; ++r) rli[r] = __builtin_amdgcn_rcpf(li_l[crow(r, hi)]);
  if (sub == 1) {
#pragma unroll
    for (int r = 0; r < 16; ++r)
#pragma unroll
      for (int d0 = 0; d0 < 4; ++d0) E[(qb * 32 + crow(r, hi)) * 128 + d0 * 32 + r32] = o[d0][r] * rli[r] * lam;
  }
  __syncthreads();
  if (sub == 0) {
#pragma unroll
    for (int r = 0; r < 16; ++r)
#pragma unroll
      for (int d0 = 0; d0 < 4; ++d0) { const int idx = (qb * 32 + crow(r, hi)) * 128 + d0 * 32 + r32; E[idx] = o[d0][r] * rli[r] - E[idx]; }
    asm volatile("s_waitcnt lgkmcnt(0)" ::: "memory");
    const float* rowp = E + (qb * 32 + r32) * 128 + hi * 64;
    f32x4 vals[16]; float ss = 0.f;
#pragma unroll
    for (int q = 0; q < 16; ++q) { vals[q] = *(const f32x4*)(rowp + 4 * q); ss += (vals[q].x * vals[q].x + vals[q].y * vals[q].y) + (vals[q].z * vals[q].z + vals[q].w * vals[q].w); }
    { auto rr = __builtin_amdgcn_permlane32_swap(__float_as_uint(ss), __float_as_uint(ss), false, false); ss = __uint_as_float(rr[0]) + __uint_as_float(rr[1]); }
    const float rstd = post / sqrtf(ss * (1.f / 128.f) + EPS);
    bf16* orow = AOg + (size_t)(qb * 32 + r32) * DM + hi * 64;
#pragma unroll
    for (int q = 0; q < 8; ++q) { const f32x4 a = vals[2 * q], b = vals[2 * q + 1]; const f32x4 ga = *(const f32x4*)(subg + hi * 64 + 8 * q), gb = *(const f32x4*)(subg + hi * 64 + 8 * q + 4);
      u32x4 w; w.x = cvtpk(a.x * rstd * ga.x, a.y * rstd * ga.y); w.y = cvtpk(a.z * rstd * ga.z, a.w * rstd * ga.w); w.z = cvtpk(b.x * rstd * gb.x, b.y * rstd * gb.y); w.w = cvtpk(b.z * rstd * gb.z, b.w * rstd * gb.w);
      *(u32x4*)(orow + 8 * q) = w; }
  }
  asm volatile("s_waitcnt vmcnt(0)" ::: "memory");
  __syncthreads();
#undef TROW
#undef DMA16
#undef ISSUE_K
#undef ISSUE_V
#undef NEXT3
#undef PIN
#undef EX
#undef PKW
#undef PAF
#undef KRD
#undef VRD
#undef VFR
#undef MF
#undef GAPA
#undef GAPB
#undef PAF_SEL
#undef STEP
}
}

__device__ __forceinline__ void phase_attention(Frame& F, ArgsP A, int l, char* lds) {
    const bf16* Q = (const bf16*)(F.ws + WS_U + SZ_QKV); const bf16* K = (const bf16*)(F.ws + WS_U + 2 * SZ_QKV); const bf16* V = (const bf16*)(F.ws + WS_U + 3 * SZ_QKV);
    bf16* AO = (bf16*)(F.ws + WS_HX);
    const float lam = ((const float*)(F.ws + WS_SMALL + SM_LAM))[l]; const float post = 1.f - (0.8f - 0.6f * expf(-0.3f * (float)l));
    const float* subg = A->in[15] + l * 128;
#define KMAXV(b, h, sb) __builtin_bit_cast(float, __hip_atomic_load((unsigned*)(F.ctl + CW_KMAX + ((l * 2 + (b)) * 8 + (h) * 2 + (sb)) * 64), RLX_AGENT))
    if (l == 0) {
        for (int u = F.c; u < 16; u += F.G) { const int bh = u & 7, qb = u >> 3, b = bh >> 2, h = bh & 3, row0 = b * NCTX + qb * 128;
            dattn::attn_unit_v4(Q + (size_t)row0 * 512 + h * 128, K + h * 128, V + h * 128, b * NCTX, 4, 0, 4, AO + (size_t)row0 * DM + 512 + h * 128, lam, subg, post, KMAXV(b, h, 0), KMAXV(b, h, 1), F.lds, lds); }
    }
    { const int x0 = (int)(xb_xcc_id() & 7u);
      volatile LAS int* tk = (volatile LAS int*)(F.MISC + 200);
      for (int k = 0; k < 8; ++k) { const int bh = (x0 + k) & 7, b = bh >> 2, h = bh & 3;
        for (;;) {
          __syncthreads();
          if (F.tid == 0) tk[0] = (int)__hip_atomic_fetch_add((unsigned*)(F.ctl + CW_TICK + (l * 8 + bh) * 64), 1u, RLX_AGENT);
          __syncthreads();
          const int qb = __builtin_amdgcn_readfirstlane(tk[0]);
          if (qb >= 128) break;
          const int row0 = MC + b * SEQ + qb * 128;
          dattn::attn_unit_v4(Q + (size_t)row0 * 512 + h * 128, K + h * 128, V + h * 128, MC + b * SEQ, SEQ / 64, b * NCTX, SEQ / 64 + NCTX / 64, AO + (size_t)row0 * DM + 512 + h * 128, lam, subg, post, KMAXV(b, h, 0), KMAXV(b, h, 1), F.lds, lds); } } }
#undef KMAXV
}

__global__ void __launch_bounds__(512, 2) fwd_kernel(Args args_unused) {
    ArgsP args = (ArgsP)__builtin_amdgcn_kernarg_segment_ptr();
    extern __shared__ __attribute__((aligned(16))) unsigned char lds[];
    Frame F;
    F.lds = (LAS unsigned char*)lds; F.MISC = (volatile LAS unsigned*)(F.lds + MISC_OFF);
    F.tid = threadIdx.x; F.lane = F.tid & 63; F.wave = __builtin_amdgcn_readfirstlane(F.tid >> 6);
    F.G = gridDim.x; F.c = blockIdx.x; F.ws = args->ws; F.ctl = (gu32*)(F.ws + WS_CTL);
    for (int u = F.tid; u < 256; u += 512) F.MISC[u] = 0u;
    __syncthreads();
#if MK_PER_PHASE || DBG_CHECK
    XcdBarrier bar; bar.bar = (unsigned*)(F.ctl + CW_BAR); bar.x = 0; bar.st = nullptr;
#define GRID_BAR() do { } while (0)
#else
    XcdBarrier bar = xcd_barrier_post((unsigned*)(F.ctl + CW_BAR), F.MISC + 8);
#define GRID_BAR() xcd_barrier(bar)
#endif
    const int lo = args->ph_lo, hi = args->ph_hi;
#ifndef KMASK
#define KMASK 0x1ff
#endif
#define KON(k) (((KMASK) >> (k)) & 1)
#ifndef REP_MASK
#define REP_MASK 0
#endif
#define NREP(k) (1 + (((REP_MASK) >> (k)) & 1))
#define IN(k) (lo <= (k) && (k) < hi)
#define SEAM(k) do { if (IN((k) + 1)) { GRID_BAR(); if (NREP(10) == 2) { GRID_BAR(); GRID_BAR(); GRID_BAR(); GRID_BAR(); } } } while (0)
    if (KON(0) && IN(0)) { if (NREP(0) == 2) { p0_prologue(F, args); GRID_BAR(); } p0_prologue(F, args); SEAM(0); }
    if (KON(1) && IN(1)) { if (NREP(1) == 2) { phase_norm1_first(F, args); GRID_BAR(); } phase_norm1_first(F, args); SEAM(1); }
#define PH_G1(l) do { \
            pg8::Gemm g{(const bf16*)(F.ws + WS_HX), (const bf16*)(F.ws + WS_WIN) + (size_t)l * DIN * DM, MT, DIN, DM}; pg8::StaticOrder S; S.init(MT, DIN, F.G, F.c); \
            EpiQKV E{(bf16*)(F.ws + WS_U), (const f32x2*)(F.ws + WS_SMALL + SM_ROPE), (unsigned*)(F.ctl + CW_KMAX + l * 16 * 64)}; \
            pg8::gemm_phase<EpiQKV, pg8::StaticOrder, true, false>(F.lds, g, S, E); } while (0)
#define PH_G2(l, DRYRUN) do { \
            const int roff = (l == NLAYER - 1) ? MC : 0; \
            pg8::Gemm g{(const bf16*)(F.ws + WS_HX) + (size_t)roff * DM, (const bf16*)(F.ws + WS_W2) + (size_t)l * DM * DM, MT - roff, DM, DM}; pg8::StaticOrder S; S.init(MT - roff, DM, F.G, F.c); \
            EpiRes E{args->in[2], args->in[0], F.ws, (bf16*)(F.ws + WS_X), l, roff, DRYRUN}; \
            pg8::gemm_phase<EpiRes, pg8::StaticOrder, true, false>(F.lds, g, S, E); } while (0)
#define PH_MA(l) do { \
            moe_setup(F, l, 2); \
            pg8::Gemm g{(const bf16*)(F.ws + WS_HX), (const bf16*)(F.ws + WS_WGU) + (size_t)l * NEXP * 512 * DM, 0, 0, DM}; \
            pg8::MoeOrder S{(const volatile LAS int*)(F.MISC + 128)}; \
            EpiGateUp E{(bf16*)(F.ws + WS_HID), (const volatile LAS float*)(F.lds + UL_OFF + 6144)}; \
            pg8::gemm_phase<EpiGateUp, pg8::MoeOrder, true, true>(F.lds, g, S, E); } while (0)
#define PH_MB(l) do { \
            moe_setup(F, l, 4); \
            pg8::Gemm g{(const bf16*)(F.ws + WS_HID), (const bf16*)(F.ws + WS_WD) + (size_t)l * NEXP * DM * DEXP, 0, 0, DEXP}; \
            pg8::MoeOrder S{(const volatile LAS int*)(F.MISC + 128)}; \
            EpiDown E{(bf16*)(F.ws + WS_U), (bf16*)(F.ws + WS_SMALL + SM_DUMMY), (const volatile LAS unsigned*)(F.lds + UL_OFF)}; \
            pg8::gemm_phase<EpiDown, pg8::MoeOrder, true, false>(F.lds, g, S, E); } while (0)
#define LAYER_BODY(l) do { \
        const int pb = 2 + 7 * l; \
        if (KON(2) && IN(pb + 0)) { if (NREP(2) == 2) { PH_G1(l); GRID_BAR(); } PH_G1(l); SEAM(pb + 0); } \
        if (KON(3) && IN(pb + 1)) { if (NREP(9) == 2) phase_pool(F); phase_pool(F); if (NREP(3) == 2) { phase_attention(F, args, l, (char*)lds); GRID_BAR(); } phase_attention(F, args, l, (char*)lds); SEAM(pb + 1); } \
        if (KON(4) && IN(pb + 2)) { if (NREP(4) == 2 && l == 0) { PH_G2(l, false); GRID_BAR(); } PH_G2(l, false); SEAM(pb + 2); } \
        if (KON(5) && IN(pb + 3)) { if (NREP(5) == 2) { phase_norm2_route<true>(F, args, l); GRID_BAR(); } phase_norm2_route<false>(F, args, l); SEAM(pb + 3); } \
        if (KON(6) && IN(pb + 4)) { if (NREP(6) == 2) { PH_MA(l); GRID_BAR(); } PH_MA(l); SEAM(pb + 4); } \
        if (KON(7) && IN(pb + 5)) { if (NREP(7) == 2) { PH_MB(l); GRID_BAR(); } PH_MB(l); SEAM(pb + 5); } \
        if (KON(8) && IN(pb + 6)) { if (NREP(8) == 2) { phase_combine<true>(F, args, l); GRID_BAR(); } phase_combine<false>(F, args, l); SEAM(pb + 6); } \
    } while (0)
    LAYER_BODY(0);
    LAYER_BODY(1);
#undef LAYER_BODY
#undef PH_G1
#undef PH_G2
#undef PH_MA
#undef PH_MB
#if !(MK_PER_PHASE || DBG_CHECK)
    if (hi == NPH) {
        if (__hip_atomic_load((unsigned*)(F.ctl + CW_BAR) + XB_TMO, RLX_AGENT) != 0u) {
            __syncthreads(); const float q = __builtin_nanf("");
            for (size_t i = (size_t)F.c * 512 + F.tid; i < (size_t)ML * DM; i += (size_t)F.G * 512) args->out[i] = q; }
    }
#endif
#undef IN
#undef SEAM
}

extern "C" void kernel_launch(void* const* d_in, const int* in_sizes, int n_in, void* d_out, int out_size, void* d_ws, size_t ws_size, hipStream_t stream) {
    static int grid = 0;
    if (grid == 0) {
        if (n_in != 25 || in_sizes[0] != ML * DM || out_size != ML * DM || ws_size < WS_END) { fprintf(stderr, "kernel_launch: shape/workspace mismatch (n_in %d, in0 %d, out %d, ws %zu < %zu)\n", n_in, n_in > 0 ? in_sizes[0] : -1, out_size, ws_size, (size_t)WS_END); grid = -1; return; }
        int dev = 0, cus = 0, per_cu = 0;
        if (hipGetDevice(&dev) != hipSuccess || hipDeviceGetAttribute(&cus, hipDeviceAttributeMultiprocessorCount, dev) != hipSuccess) { grid = -1; return; }
        if (hipFuncSetAttribute((const void*)fwd_kernel, hipFuncAttributeMaxDynamicSharedMemorySize, LDS_BYTES) != hipSuccess) { fprintf(stderr, "kernel_launch: hipFuncSetAttribute failed\n"); grid = -1; return; }
        if (hipOccupancyMaxActiveBlocksPerMultiprocessor(&per_cu, (const void*)fwd_kernel, 512, LDS_BYTES) != hipSuccess || per_cu < 1) { fprintf(stderr, "kernel_launch: occupancy query says %d\n", per_cu); }
        (void)hipGetLastError();
        grid = cus;
    }
    if (grid < 0) return;
    (void)hipMemsetAsync((char*)d_ws + WS_CTL, 0, CTL_ZERO_BYTES, stream);
    Args a{};
    for (int i = 0; i < 25; ++i) a.in[i] = (const float*)d_in[i];
    a.out = (float*)d_out; a.ws = (unsigned char*)d_ws;
#if MK_PER_PHASE || DBG_CHECK
    for (int p = 0; p < NPH; ++p) { a.ph_lo = p; a.ph_hi = p + 1; hipLaunchKernelGGL(fwd_kernel, dim3(grid), dim3(512), LDS_BYTES, stream, a); }
#else
    a.ph_lo = 0; a.ph_hi = NPH; hipLaunchKernelGGL(fwd_kernel, dim3(grid), dim3(512), LDS_BYTES, stream, a);
#endif
}
```
